# Optimizing an MI355X kernel written in HIP

```python
import math
import jax, jax.numpy as jnp
from jax import lax
import numpy as np

D_MODEL = 1024
BATCH = 2
SEQ = 8192
DEPTH = 1

EPS = 1e-6
Q_BLOCK = 128
MLA_HEADS = 8
MLA_NOPE_DIM = 64
MLA_ROPE_DIM = 32
MLA_V_DIM = 64
Q_LORA_RANK = 256
KV_LORA_RANK = 128
ROPE_THETA = 10000.0
MLA_QK_DIM = MLA_NOPE_DIM + MLA_ROPE_DIM
SB_HEADS = 8
SB_HEAD_DIM = 64
MLA_WIDTH = MLA_HEADS * MLA_V_DIM
SB_WIDTH = SB_HEADS * SB_HEAD_DIM
MIX_WIDTH = MLA_WIDTH + SB_WIDTH
IN_SPLITS = (Q_LORA_RANK, KV_LORA_RANK, MLA_ROPE_DIM, SB_WIDTH, SB_WIDTH, SB_WIDTH)
IN_PROJ_WIDTH = sum(IN_SPLITS)
IN_SPLIT_POINTS = tuple(int(v) for v in np.cumsum(IN_SPLITS)[:-1])
D_FF = ((8 * D_MODEL + 3 * 256 - 1) // (3 * 256)) * 256

kernel_name = "hymba_mla_stickbreaking_swiglu"


def rmsnorm(x, g):
    xf = x.astype(jnp.float32)
    y = xf * lax.rsqrt(jnp.mean(xf * xf, axis=-1, keepdims=True) + EPS)
    return (y * g.astype(jnp.float32)).astype(x.dtype)


def rope_tables(positions, dim):
    inv_freq = ROPE_THETA ** (-jnp.arange(0, dim, 2, dtype=jnp.float32) / dim)
    ang = positions.astype(jnp.float32)[:, :, None] * inv_freq[None, None, :]
    return jnp.cos(ang)[:, None], jnp.sin(ang)[:, None]


def apply_rope(x, cos, sin):
    xf = x.astype(jnp.float32)
    x1, x2 = jnp.split(xf, 2, axis=-1)
    out = jnp.concatenate([x1 * cos - x2 * sin, x2 * cos + x1 * sin], axis=-1)
    return out.astype(x.dtype)


def to_query_blocks(q):
    b, h, s, d = q.shape
    return q.reshape(b, h, s // Q_BLOCK, Q_BLOCK, d).transpose(2, 0, 1, 3, 4)


def from_query_blocks(o):
    nb, b, h, qb, d = o.shape
    return o.transpose(1, 2, 0, 3, 4).reshape(b, h, nb * qb, d)


def mla_causal_attention(q, k, v):
    seq = q.shape[2]
    scale = 1.0 / math.sqrt(q.shape[-1])
    kf = k.astype(jnp.float32)
    vf = v.astype(jnp.float32)
    k_pos = jnp.arange(seq)
    nb = seq // Q_BLOCK

    def block(args):
        i, qb = args
        s = jnp.einsum("bhqd,bhkd->bhqk", qb.astype(jnp.float32), kf) * scale
        q_pos = i * Q_BLOCK + jnp.arange(Q_BLOCK)
        causal = k_pos[None, :] <= q_pos[:, None]
        p = jax.nn.softmax(jnp.where(causal, s, -jnp.inf), axis=-1)
        return jnp.einsum("bhqk,bhkd->bhqd", p, vf)

    o = lax.map(block, (jnp.arange(nb), to_query_blocks(q)))
    return from_query_blocks(o).astype(q.dtype)


def stick_breaking_attention(q, k, v):
    seq = q.shape[2]
    scale = 1.0 / math.sqrt(q.shape[-1])
    kf = k.astype(jnp.float32)
    vf = v.astype(jnp.float32)
    k_pos = jnp.arange(seq)
    nb = seq // Q_BLOCK

    def block(args):
        i, qb = args
        z = jnp.einsum("bhqd,bhkd->bhqk", qb.astype(jnp.float32), kf) * scale
        q_pos = i * Q_BLOCK + jnp.arange(Q_BLOCK)
        strict = k_pos[None, :] < q_pos[:, None]
        log_beta = jax.nn.log_sigmoid(z)
        log_one_minus = jnp.where(strict, jax.nn.log_sigmoid(-z), 0.0)
        suffix = lax.cumsum(log_one_minus, axis=3, reverse=True) - log_one_minus
        a = jnp.where(strict, jnp.exp(log_beta + suffix), 0.0)
        return jnp.einsum("bhqk,bhkd->bhqd", a, vf)

    o = lax.map(block, (jnp.arange(nb), to_query_blocks(q)))
    return from_query_blocks(o).astype(q.dtype)


def split_heads(t, n_heads):
    b, s, _ = t.shape
    return t.reshape(b, s, n_heads, -1).transpose(0, 2, 1, 3)


def merge_heads(t):
    b, h, s, d = t.shape
    return t.transpose(0, 2, 1, 3).reshape(b, s, h * d)


def setup_inputs(seed: int = 0) -> dict:
    key = jax.random.key(seed)
    ks = jax.random.split(key, 20)
    f32 = jnp.float32

    def w(k, shape, fan_in):
        return jax.random.normal(k, shape, f32) * (fan_in ** -0.5)

    def gain(k, shape):
        return 1.0 + 0.02 * jax.random.normal(k, shape, f32)

    x = jax.random.normal(ks[0], (BATCH, SEQ, D_MODEL), f32)
    positions = jnp.broadcast_to(jnp.arange(SEQ, dtype=jnp.int32), (BATCH, SEQ))
    return {
        "x": x,
        "positions": positions,
        "norm_mix": gain(ks[1], (DEPTH, D_MODEL)),
        "w_in": w(ks[2], (DEPTH, D_MODEL, IN_PROJ_WIDTH), D_MODEL),
        "q_latent_norm": gain(ks[3], (DEPTH, Q_LORA_RANK)),
        "w_uq": w(ks[4], (DEPTH, Q_LORA_RANK, MLA_HEADS * MLA_QK_DIM), Q_LORA_RANK),
        "kv_latent_norm": gain(ks[5], (DEPTH, KV_LORA_RANK)),
        "w_ukv": w(ks[6], (DEPTH, KV_LORA_RANK, MLA_HEADS * (MLA_NOPE_DIM + MLA_V_DIM)), KV_LORA_RANK),
        "out_norm_mla": gain(ks[7], (DEPTH, MLA_WIDTH)),
        "out_norm_sb": gain(ks[8], (DEPTH, SB_WIDTH)),
        "w_o": w(ks[9], (DEPTH, MIX_WIDTH, D_MODEL), MIX_WIDTH),
        "norm_ffn": gain(ks[10], (DEPTH, D_MODEL)),
        "w_gate": w(ks[11], (DEPTH, D_MODEL, D_FF), D_MODEL),
        "w_up": w(ks[12], (DEPTH, D_MODEL, D_FF), D_MODEL),
        "w_down": w(ks[13], (DEPTH, D_FF, D_MODEL), D_FF),
        "norm_final": gain(ks[14], (D_MODEL,)),
    }


def reference(x, positions, norm_mix, w_in, q_latent_norm, w_uq, kv_latent_norm,
              w_ukv, out_norm_mla, out_norm_sb, w_o, norm_ffn, w_gate, w_up,
              w_down, norm_final):
    b, s, _ = x.shape
    cos, sin = rope_tables(positions, MLA_ROPE_DIM)
    h = x
    for l in range(DEPTH):
        u = rmsnorm(h, norm_mix[l])
        proj = jnp.einsum("bsd,de->bse", u, w_in[l])
        c_q, c_kv, k_r, q_sb, k_sb, v_sb = jnp.split(proj, IN_SPLIT_POINTS, axis=-1)

        q = split_heads(jnp.einsum("bsr,re->bse", rmsnorm(c_q, q_latent_norm[l]), w_uq[l]), MLA_HEADS)
        q_nope, q_rope = q[..., :MLA_NOPE_DIM], q[..., MLA_NOPE_DIM:]
        q_rope = apply_rope(q_rope, cos, sin)
        kv = split_heads(jnp.einsum("bsr,re->bse", rmsnorm(c_kv, kv_latent_norm[l]), w_ukv[l]), MLA_HEADS)
        k_nope, v_mla = kv[..., :MLA_NOPE_DIM], kv[..., MLA_NOPE_DIM:]
        k_rope = apply_rope(k_r[:, None], cos, sin)
        q_mla = jnp.concatenate([q_nope, q_rope], axis=-1)
        k_mla = jnp.concatenate([k_nope, jnp.broadcast_to(k_rope, (b, MLA_HEADS, s, MLA_ROPE_DIM))], axis=-1)
        o_mla = merge_heads(mla_causal_attention(q_mla, k_mla, v_mla))

        o_sb = merge_heads(stick_breaking_attention(
            split_heads(q_sb, SB_HEADS), split_heads(k_sb, SB_HEADS), split_heads(v_sb, SB_HEADS)))

        merged = jnp.concatenate([rmsnorm(o_mla, out_norm_mla[l]), rmsnorm(o_sb, out_norm_sb[l])], axis=-1)
        h = h + jnp.einsum("bse,ed->bsd", merged, w_o[l])

        f = rmsnorm(h, norm_ffn[l])
        gate = jnp.einsum("bsd,df->bsf", f, w_gate[l])
        up = jnp.einsum("bsd,df->bsf", f, w_up[l])
        h = h + jnp.einsum("bsf,fd->bsd", jax.nn.silu(gate) * up, w_down[l])
    return rmsnorm(h, norm_final)
```

```cpp
#include <hip/hip_runtime.h>
#include <hip/hip_cooperative_groups.h>
#include <cstdio>
#include <cstdint>
namespace cg = cooperative_groups;

namespace pg8 {
#define PG8_LAS __attribute__((address_space(3)))
typedef unsigned short bf16_t;
typedef short bf16x8 __attribute__((ext_vector_type(8)));
typedef float f32x4 __attribute__((ext_vector_type(4)));
typedef unsigned u32x4 __attribute__((ext_vector_type(4)));
typedef unsigned u32x2 __attribute__((ext_vector_type(2)));
constexpr int BM = 256, BK = 64, HALF = 128, HTB = HALF * BK * 2, STAGE_BYTES = 8 * HTB, NXCD = 8, WGM = 8;

__host__ __device__ __forceinline__ int lds_byte(int r, int c) { const int st = (r >> 4) * 2 + (c >> 5), rr = r & 15, cc = c & 31, ob = rr * 64 + cc * 2; return st * 1024 + (ob ^ (((ob >> 9) & 1) << 5)); }
__host__ __device__ __forceinline__ void stage_rc(int b, int& R, int& C) { const int st = b / 1024, sb = b % 1024, swz = sb ^ (((sb >> 9) & 1) << 5); R = (st >> 1) * 16 + swz / 64; C = (st & 1) * 32 + (swz % 64) / 2; }
__host__ __device__ __forceinline__ int perm32(int rho) { const int n = rho >> 4, i = rho & 15; return 8 * (i >> 2) + 4 * n + (i & 3); }

struct Unit { int pm, pn; };
struct Gemm { const bf16_t* A; const bf16_t* Bt; int M, N, K; };

struct StaticOrder {
    int nM, nN, nwg, G, c;
    __host__ __device__ void init(int M, int N, int G_, int c_) { nM = M / BM; nN = N / BM; nwg = nM * nN; G = G_; c = c_; }
    __host__ __device__ bool next(int i, Unit& u) const {
        const long L = (long)i * G + c; if (L >= nwg) return false;
        int wgid = (int)L; { const int q = nwg / NXCD, r = nwg % NXCD, xcd = wgid % NXCD, off = wgid / NXCD; wgid = (xcd < r ? xcd * (q + 1) : r * (q + 1) + (xcd - r) * q) + off; }
        const int nig = WGM * nN, gid = wgid / nig, fm = gid * WGM, gsz = (nM - fm) < WGM ? (nM - fm) : WGM;
        u.pm = fm + ((wgid % nig) % gsz); u.pn = (wgid % nig) / gsz; return true;
    }
    __device__ __forceinline__ void a_ready(const Unit&) const {}
    __device__ __forceinline__ void done(const Unit&) const {}
};

typedef float f32x2_t __attribute__((ext_vector_type(2))); typedef __bf16 bf16x2_t __attribute__((ext_vector_type(2)));
__device__ __forceinline__ unsigned cvtpk(float lo, float hi) { f32x2_t v = {lo, hi}; bf16x2_t b = __builtin_convertvector(v, bf16x2_t); return __builtin_bit_cast(unsigned, b); }
__device__ __forceinline__ void store8(bf16_t* p, f32x4 v0, f32x4 v1) { u32x4 w; w.x = cvtpk(v0[0], v0[1]); w.y = cvtpk(v0[2], v0[3]); w.z = cvtpk(v1[0], v1[1]); w.w = cvtpk(v1[2], v1[3]); *(u32x4*)p = w; }
__device__ __forceinline__ void store4(bf16_t* p, f32x4 v0) { u32x2 w; w.x = cvtpk(v0[0], v0[1]); w.y = cvtpk(v0[2], v0[3]); *(u32x2*)p = w; }
__device__ __forceinline__ const char* uptr(const char* p) { const unsigned long long v = (unsigned long long)p; const unsigned lo = __builtin_amdgcn_readfirstlane((unsigned)v), hi = __builtin_amdgcn_readfirstlane((unsigned)(v >> 32)); return (const char*)(((unsigned long long)hi << 32) | lo); }

template <class Epi, class Sched, bool ALIGN_EPI = false, bool SP2 = false>
__device__ __forceinline__ void gemm_phase(PG8_LAS unsigned char* lds, const Gemm g, const Sched& S, const Epi& E) {
    const int tid = threadIdx.x, wid = __builtin_amdgcn_readfirstlane(tid >> 6), lane = tid & 63, wr = wid >> 2, wc = wid & 3, fr = lane & 15, fq = lane >> 4;
    const int K = g.K, nt = K / BK;
    unsigned voffA[2], voffB[2];
#pragma unroll
    for (int i = 0; i < 2; ++i) { int R, C; stage_rc(tid * 16 + i * 8192, R, C); const int Rb = Epi::PERM ? ((R & ~31) + perm32(R & 31)) : R;
        voffA[i] = (unsigned)(R * K + C) * 2u; voffB[i] = (unsigned)(Rb * K + C) * 2u; }
    const size_t kstep = (size_t)(BK * 2);
    const size_t hstep = (size_t)HALF * K * 2;
    const size_t tstep = 2 * hstep;
    const unsigned ldsw = (unsigned)wid * 1024u;
    const int aoff = lds_byte(wr * 64 + fr, fq * 8), boff = lds_byte(wc * 32 + fr, fq * 8);
#define PG8_SA(b, h) (((b) * 2 + (h)) * HTB)
#define PG8_SB(b, h) ((4 + (b) * 2 + (h)) * HTB)
#define PG8_STAGE(bufoff, gbase, voff) do { _Pragma("unroll") for (int _i = 0; _i < 2; ++_i) \
        __builtin_amdgcn_global_load_lds((const unsigned*)((const char*)(gbase) + (voff)[_i]), (PG8_LAS unsigned*)(lds + (bufoff) + ldsw + _i * 8192), 16, 0, 0); } while (0)
#define PG8_LDA(dst, b, h) do { _Pragma("unroll") for (int m = 0; m < 4; ++m) _Pragma("unroll") for (int k = 0; k < 2; ++k) dst[m][k] = *(const PG8_LAS bf16x8*)(lds + PG8_SA(b, h) + aoff + m * 2048 + k * 1024); } while (0)
#define PG8_LDB(dst, b, h) do { _Pragma("unroll") for (int n = 0; n < 2; ++n) _Pragma("unroll") for (int k = 0; k < 2; ++k) dst[n][k] = *(const PG8_LAS bf16x8*)(lds + PG8_SB(b, h) + boff + n * 2048 + k * 1024); } while (0)
#define PG8_MMA(ai, bj, At, Bt) do { __builtin_amdgcn_s_setprio(1); _Pragma("unroll") for (int m = 0; m < 4; ++m) _Pragma("unroll") for (int n = 0; n < 2; ++n) _Pragma("unroll") for (int k = 0; k < 2; ++k) \
        acc[ai][bj][m][n] = __builtin_amdgcn_mfma_f32_16x16x32_bf16(Bt[n][k], At[m][k], acc[ai][bj][m][n], 0, 0, 0); __builtin_amdgcn_s_setprio(0); } while (0)
#define PG8_WAIT_V(n) asm volatile("s_waitcnt vmcnt(" #n ")" ::: "memory")
#define PG8_WAIT_L(n) asm volatile("s_waitcnt lgkmcnt(" #n ")" ::: "memory")
#define PG8_BAR __builtin_amdgcn_s_barrier()
#define PG8_SCHED __builtin_amdgcn_sched_barrier(0)
    Unit cur, nxt; int ui = 0;
    if (!S.next(0, cur)) return;
    f32x4 acc[2][2][4][2];
#pragma unroll
    for (int a = 0; a < 2; ++a)
#pragma unroll
        for (int b = 0; b < 2; ++b)
#pragma unroll
            for (int m = 0; m < 4; ++m)
#pragma unroll
                for (int n = 0; n < 2; ++n) acc[a][b][m][n] = (f32x4){0.f, 0.f, 0.f, 0.f};
    bf16x8 At[4][2], B0[2][2], B1[2][2];
    const char* cA = uptr((const char*)g.A + (size_t)cur.pm * tstep); const char* cB = uptr((const char*)g.Bt + (size_t)cur.pn * tstep);
    S.a_ready(cur);
    if constexpr (SP2) {
        PG8_STAGE(PG8_SB(0, 0), cB, voffB); PG8_STAGE(PG8_SB(0, 1), cB + hstep, voffB); PG8_STAGE(PG8_SA(0, 0), cA, voffA); PG8_STAGE(PG8_SA(0, 1), cA + hstep, voffA);
        if (wr == 1) PG8_BAR;
        PG8_WAIT_V(2); PG8_BAR;
        PG8_STAGE(PG8_SB(1, 0), cB + kstep, voffB); PG8_STAGE(PG8_SA(1, 0), cA + kstep, voffA); PG8_STAGE(PG8_SB(1, 1), cB + hstep + kstep, voffB);
        PG8_WAIT_V(6); PG8_BAR;
    } else {
        PG8_STAGE(PG8_SB(0, 0), cB, voffB); PG8_STAGE(PG8_SA(0, 0), cA, voffA); PG8_STAGE(PG8_SB(0, 1), cB + hstep, voffB); PG8_STAGE(PG8_SA(0, 1), cA + hstep, voffA);
        if (wr == 1) PG8_BAR;
        PG8_WAIT_V(4); PG8_BAR;
        PG8_STAGE(PG8_SB(1, 0), cB + kstep, voffB); PG8_STAGE(PG8_SA(1, 0), cA + kstep, voffA); PG8_STAGE(PG8_SB(1, 1), cB + hstep + kstep, voffB);
        PG8_WAIT_V(6); PG8_BAR;
    }
    for (;;) {
        const bool has_next = S.next(ui + 1, nxt);
        const char* nA = uptr(has_next ? (const char*)g.A + (size_t)nxt.pm * tstep : cA); const char* nB = uptr(has_next ? (const char*)g.Bt + (size_t)nxt.pn * tstep : cB);
#pragma unroll 1
        for (int t = 0; t < nt; t += 2) {
            const bool last = (t == nt - 2);
            if constexpr (Epi::MID) { if (t == (nt >> 1)) E.mid(acc, cur, wr, wc, fr, fq); }
            const char* a1 = cA + (size_t)(t + 1) * kstep;
            const char* a2 = last ? nA : cA + (size_t)(t + 2) * kstep; const char* b2 = last ? nB : cB + (size_t)(t + 2) * kstep;
            const char* a3 = a2 + kstep; const char* b3 = b2 + kstep;
            if (last && has_next) S.a_ready(nxt);
            if constexpr (SP2) {
            PG8_LDB(B0, 0, 0); PG8_LDB(B1, 0, 1); PG8_SCHED; PG8_LDA(At, 0, 0); PG8_STAGE(PG8_SA(1, 1), a1 + hstep, voffA);
            PG8_WAIT_V(8); PG8_WAIT_L(0); PG8_BAR; PG8_MMA(0, 0, At, B0); PG8_MMA(0, 1, At, B1); PG8_BAR; PG8_SCHED;
            PG8_LDA(At, 0, 1); PG8_STAGE(PG8_SB(0, 0), b2, voffB); PG8_STAGE(PG8_SB(0, 1), b2 + hstep, voffB); PG8_STAGE(PG8_SA(0, 0), a2, voffA);
            PG8_WAIT_V(8); PG8_WAIT_L(0); PG8_BAR; PG8_MMA(1, 0, At, B0); PG8_MMA(1, 1, At, B1); PG8_BAR; PG8_SCHED;
            PG8_LDB(B0, 1, 0); PG8_LDB(B1, 1, 1); PG8_SCHED; PG8_LDA(At, 1, 0); PG8_STAGE(PG8_SA(0, 1), a2 + hstep, voffA);
            PG8_WAIT_V(8); PG8_WAIT_L(0); PG8_BAR; PG8_MMA(0, 0, At, B0); PG8_MMA(0, 1, At, B1); PG8_BAR; PG8_SCHED;
            PG8_LDA(At, 1, 1); PG8_STAGE(PG8_SB(1, 0), b3, voffB); PG8_STAGE(PG8_SB(1, 1), b3 + hstep, voffB); PG8_STAGE(PG8_SA(1, 0), a3, voffA);
            PG8_WAIT_V(8); PG8_WAIT_L(0); PG8_BAR; PG8_MMA(1, 0, At, B0); PG8_MMA(1, 1, At, B1); PG8_BAR; PG8_SCHED;
            } else {
            PG8_LDB(B0, 0, 0); PG8_SCHED; PG8_LDA(At, 0, 0); PG8_STAGE(PG8_SA(1, 1), a1 + hstep, voffA);
            PG8_WAIT_L(8); PG8_BAR; PG8_WAIT_L(0); PG8_MMA(0, 0, At, B0); PG8_BAR; PG8_SCHED;
            PG8_LDB(B1, 0, 1); PG8_STAGE(PG8_SB(0, 0), b2, voffB);
            PG8_BAR; PG8_WAIT_L(0); PG8_MMA(0, 1, At, B1); PG8_BAR;
            PG8_LDA(At, 0, 1); PG8_STAGE(PG8_SA(0, 0), a2, voffA);
            PG8_BAR; PG8_WAIT_L(0); PG8_MMA(1, 0, At, B0); PG8_BAR; PG8_SCHED;
            PG8_STAGE(PG8_SB(0, 1), b2 + hstep, voffB);
            PG8_WAIT_V(6); PG8_BAR; PG8_MMA(1, 1, At, B1); PG8_BAR;
            PG8_LDB(B0, 1, 0); PG8_SCHED; PG8_LDA(At, 1, 0); PG8_STAGE(PG8_SA(0, 1), a2 + hstep, voffA);
            PG8_WAIT_L(8); PG8_BAR; PG8_WAIT_L(0); PG8_MMA(0, 0, At, B0); PG8_BAR; PG8_SCHED;
            PG8_LDB(B1, 1, 1); PG8_STAGE(PG8_SB(1, 0), b3, voffB);
            PG8_BAR; PG8_WAIT_L(0); PG8_MMA(0, 1, At, B1); PG8_BAR;
            PG8_LDA(At, 1, 1); PG8_STAGE(PG8_SA(1, 0), a3, voffA);
            PG8_BAR; PG8_WAIT_L(0); PG8_MMA(1, 0, At, B0); PG8_BAR; PG8_SCHED;
            PG8_STAGE(PG8_SB(1, 1), b3 + hstep, voffB);
            PG8_WAIT_V(6); PG8_BAR; PG8_MMA(1, 1, At, B1); PG8_BAR;
            }
        }
        if constexpr (ALIGN_EPI) { if (wr == 0) PG8_BAR; }
        if constexpr (!Epi::AFTER_DRAIN) { E(acc, cur, wr, wc, fr, fq); S.done(cur); }
        if (!has_next) break;
#pragma unroll
        for (int a = 0; a < 2; ++a)
#pragma unroll
            for (int b = 0; b < 2; ++b)
#pragma unroll
                for (int m = 0; m < 4; ++m)
#pragma unroll
                    for (int n = 0; n < 2; ++n) acc[a][b][m][n] = (f32x4){0.f, 0.f, 0.f, 0.f};
        cur = nxt; cA = nA; cB = nB; ++ui;
        if constexpr (ALIGN_EPI) { if (wr == 1) PG8_BAR; }
    }
    PG8_WAIT_V(0);
    if constexpr (!ALIGN_EPI) { if (wr == 0) PG8_BAR; }
    PG8_BAR;
    if constexpr (Epi::AFTER_DRAIN) { E.fused(acc, cur, wr, wc, fr, fq, lds, wid, lane); S.done(cur); }
#undef PG8_SA
#undef PG8_SB
#undef PG8_STAGE
#undef PG8_LDA
#undef PG8_LDB
#undef PG8_MMA
#undef PG8_WAIT_V
#undef PG8_WAIT_L
#undef PG8_BAR
#undef PG8_SCHED
}
}

constexpr int BATCH = 2, SEQ = 8192, M = BATCH * SEQ, DM = 1024, DFF = 2816;
constexpr int N_IN = 2048, N_UP = 1792, K_UP = 384, N_GU = 2 * DFF;
constexpr float EPS = 1e-6f;
constexpr float C2Q = 0.1472444460259031f;
constexpr float C2S = 0.18033688011112042f;

constexpr size_t MiB = 1u << 20;
constexpr size_t WS_CTL = 0, CTL_ZERO_BYTES = 544 * 1024;
constexpr size_t OFF_SSQ_CQ = 0, OFF_SSQ_CKV = 65536, OFF_SSQ_MLA = 131072, OFF_SSQ_SB = 196608, OFF_SSQ_H1 = 262144, OFF_SSQ_H2 = 327680, OFF_CTR = 393216, OFF_CNT = 409600, OFF_SSQ_X = 458752, OFF_BAR = 524288;
constexpr size_t WS_WIN = 2 * MiB;
constexpr size_t WS_WUP = 6 * MiB;
constexpr size_t WS_WO = 8 * MiB;
constexpr size_t WS_WGU = 10 * MiB;
constexpr size_t WS_WD = 22 * MiB;
constexpr size_t WS_CS = 28 * MiB;
constexpr size_t WS_XN = 32 * MiB;
constexpr size_t WS_CQKV = 64 * MiB;
constexpr size_t WS_KR = 76 * MiB;
constexpr size_t WS_QSB = 80 * MiB, WS_KSB = 96 * MiB, WS_VSB = 112 * MiB;
constexpr size_t WS_QMLA = 128 * MiB;
constexpr size_t WS_KVMLA = 152 * MiB;
constexpr size_t WS_OMIX = 184 * MiB;
constexpr size_t WS_ACT = 64 * MiB;
constexpr size_t WS_H1B = 216 * MiB;
constexpr size_t WS_END = 248 * MiB;
static_assert(WS_ACT + (size_t)M * DFF * 2 <= WS_KVMLA + 32 * MiB && WS_ACT + (size_t)M * DFF * 2 <= WS_OMIX, "ACT overlay");
#define WSP(T, off) ((T*)(ws + (off)))

using pg8::bf16_t; using pg8::bf16x8; using pg8::f32x4; using pg8::u32x4; using pg8::u32x2; using pg8::Unit; using pg8::cvtpk; using pg8::store8; using pg8::store4;
#define LAS __attribute__((address_space(3)))

__device__ __forceinline__ float rsq(float x) { return __builtin_amdgcn_rsqf(x); }

__device__ __forceinline__ f32x4 rope4(f32x4 v, const float2* cs4, float sg) {
    f32x4 r;
#pragma unroll
    for (int e = 0; e < 4; ++e) { const float oth = __shfl_xor(v[e], 32); const float2 c = cs4[e]; r[e] = v[e] * c.x + sg * (oth * c.y); }
    return r;
}
__device__ __forceinline__ f32x4 ld4bf(const bf16_t* p) { const u32x2 w = *(const u32x2*)p; return (f32x4){__uint_as_float(w.x << 16), __uint_as_float(w.x & 0xffff0000u), __uint_as_float(w.y << 16), __uint_as_float(w.y & 0xffff0000u)}; }
__device__ __forceinline__ float sq4(f32x4 v) { return (v[0] * v[0] + v[1] * v[1]) + (v[2] * v[2] + v[3] * v[3]); }
#define EPI_LANE() int fr = fr_in, fq = fq_in; asm volatile("" : "+v"(fr), "+v"(fq))

struct EpiProj {
    static constexpr bool PERM = true, AFTER_DRAIN = false, MID = false;
    unsigned char* ws;
    __device__ __forceinline__ void operator()(const f32x4 (&acc)[2][2][4][2], const Unit& u, int wr, int wc, int fr_in, int fq_in) const {
        EPI_LANE();
        const int pn = u.pn, row0 = u.pm * 256 + wr * 64 + fr;
#define RSX(ai, m) rsq(WSP(const float, OFF_SSQ_X)[(unsigned)(row0 + (ai) * 128 + (m) * 16)] * (1.f / DM) + EPS)
        if (pn >= 2) {
            const int t = (pn - 2) >> 1; bf16_t* base = WSP(bf16_t, WS_QSB) + (size_t)t * ((WS_KSB - WS_QSB) / 2); const float sc = (t == 0) ? C2S : 1.f;
            const int col0 = ((pn - 2) & 1) * 256 + wc * 32 + 8 * fq;
#pragma unroll
            for (int ai = 0; ai < 2; ++ai)
#pragma unroll
                for (int m = 0; m < 4; ++m) { bf16_t* rowp = base + (unsigned)((row0 + ai * 128 + m * 16) * 512 + col0); const float sr = sc * RSX(ai, m);
#pragma unroll
                    for (int bj = 0; bj < 2; ++bj) store8(rowp + bj * 128, acc[ai][bj][m][0] * sr, acc[ai][bj][m][1] * sr);
                    asm volatile("" ::: "memory"); }
        } else if (pn == 0) {
            const int col0 = wc * 32 + 8 * fq;
#pragma unroll
            for (int ai = 0; ai < 2; ++ai)
#pragma unroll
                for (int m = 0; m < 4; ++m) { const int row = row0 + ai * 128 + m * 16; bf16_t* rowp = WSP(bf16_t, WS_CQKV) + (unsigned)(row * 256 + col0); float ss = 0.f; const float sr = RSX(ai, m);
#pragma unroll
                    for (int bj = 0; bj < 2; ++bj) { const f32x4 v0 = acc[ai][bj][m][0] * sr, v1 = acc[ai][bj][m][1] * sr; ss += sq4(v0) + sq4(v1); store8(rowp + bj * 128, v0, v1); }
                    ss += __shfl_xor(ss, 16); ss += __shfl_xor(ss, 32);
                    if (fq == 0) atomicAdd(WSP(float, OFF_SSQ_CQ) + (unsigned)row, ss); }
        } else {
            const int col0 = wc * 32 + 8 * fq; const float sg = (fq < 2) ? -1.f : 1.f;
#pragma unroll
            for (int ai = 0; ai < 2; ++ai)
#pragma unroll
                for (int m = 0; m < 4; ++m) { const int row = row0 + ai * 128 + m * 16;
                    const float sr = RSX(ai, m);
                    const f32x4 c0 = acc[ai][0][m][0] * sr, c1 = acc[ai][0][m][1] * sr;
                    float ss = sq4(c0) + sq4(c1);
                    store8(WSP(bf16_t, WS_CQKV) + (unsigned)(M * 256 + row * 128 + col0), c0, c1);
                    ss += __shfl_xor(ss, 16); ss += __shfl_xor(ss, 32);
                    if (fq == 0) atomicAdd(WSP(float, OFF_SSQ_CKV) + (unsigned)row, ss);
                    if (wc == 0) { const float2* cs = WSP(const float2, WS_CS) + (unsigned)(row * 16 + 8 * (fq & 1));
                        const f32x4 v0 = rope4(acc[ai][1][m][0] * sr, cs, sg), v1 = rope4(acc[ai][1][m][1] * sr, cs + 4, sg); store8(WSP(bf16_t, WS_KR) + (unsigned)(row * 32 + 8 * fq), v0, v1); }
                    asm volatile("" ::: "memory"); }
        }
    }
};

struct EpiUp {
    static constexpr bool PERM = true, AFTER_DRAIN = false, MID = false;
    unsigned char* ws; int pn_off;
    __device__ __forceinline__ void operator()(const f32x4 (&acc)[2][2][4][2], const Unit& u, int wr, int wc, int fr_in, int fq_in) const {
        EPI_LANE();
        const int pn = u.pn + pn_off, row0 = u.pm * 256 + wr * 64 + fr;
        if (pn < 3) {
            const float sg = (fq < 2) ? -1.f : 1.f;
#pragma unroll
            for (int ai = 0; ai < 2; ++ai)
#pragma unroll
                for (int m = 0; m < 4; ++m) { const int row = row0 + ai * 128 + m * 16; const float rs = rsq(WSP(const float, OFF_SSQ_CQ)[(unsigned)row] * (1.f / 256.f) + EPS);
#pragma unroll
                    for (int bj = 0; bj < 2; ++bj) { const int G = 8 * pn + 4 * bj + wc; f32x4 v0 = acc[ai][bj][m][0] * rs, v1 = acc[ai][bj][m][1] * rs;
                        if ((G % 3) == 2) { const float2* cs = WSP(const float2, WS_CS) + (unsigned)(row * 16 + 8 * (fq & 1)); v0 = rope4(v0, cs, sg); v1 = rope4(v1, cs + 4, sg); }
                        store8(WSP(bf16_t, WS_QMLA) + (unsigned)(row * 768 + 32 * G + 8 * fq), v0 * C2Q, v1 * C2Q);
                        asm volatile("" ::: "memory"); } }
        } else {
            const int col0 = (pn - 3) * 256 + wc * 32 + 8 * fq;
#pragma unroll
            for (int ai = 0; ai < 2; ++ai)
#pragma unroll
                for (int m = 0; m < 4; ++m) { const int row = row0 + ai * 128 + m * 16; const float rs = rsq(WSP(const float, OFF_SSQ_CKV)[(unsigned)row] * (1.f / 128.f) + EPS);
#pragma unroll
                    for (int bj = 0; bj < 2; ++bj) store8(WSP(bf16_t, WS_KVMLA) + (unsigned)(row * 1024 + col0 + bj * 128), acc[ai][bj][m][0] * rs, acc[ai][bj][m][1] * rs);
                    asm volatile("" ::: "memory"); }
        }
    }
};

struct EpiWo {
    static constexpr bool PERM = false, AFTER_DRAIN = false, MID = true;
    const float* x; float* h1; unsigned char* ws;
    __device__ __forceinline__ void mid(f32x4 (&acc)[2][2][4][2], const Unit& u, int wr, int wc, int fr_in, int fq_in) const {
        EPI_LANE();
        const int row0 = u.pm * 256 + wr * 64 + fr;
#pragma unroll
        for (int ai = 0; ai < 2; ++ai)
#pragma unroll
            for (int m = 0; m < 4; ++m) { const int row = row0 + ai * 128 + m * 16;
                const float a = WSP(const float, OFF_SSQ_MLA)[(unsigned)row] * (1.f / 512.f) + EPS, b = WSP(const float, OFF_SSQ_SB)[(unsigned)row] * (1.f / 512.f) + EPS; const float ratio = __builtin_sqrtf(b) * rsq(a);
#pragma unroll
                for (int bj = 0; bj < 2; ++bj)
#pragma unroll
                    for (int n = 0; n < 2; ++n) acc[ai][bj][m][n] *= ratio;
                asm volatile("" ::: "memory"); }
    }
    __device__ __forceinline__ void operator()(const f32x4 (&acc)[2][2][4][2], const Unit& u, int wr, int wc, int fr_in, int fq_in) const {
        EPI_LANE();
        const int row0 = u.pm * 256 + wr * 64 + fr, col0 = u.pn * 256 + wc * 32 + 4 * fq;
#pragma unroll
        for (int ai = 0; ai < 2; ++ai)
#pragma unroll
            for (int m = 0; m < 4; ++m) { const int row = row0 + ai * 128 + m * 16; const float rs = rsq(WSP(const float, OFF_SSQ_SB)[(unsigned)row] * (1.f / 512.f) + EPS); float ss = 0.f; const unsigned off = (unsigned)(row * DM + col0);
#pragma unroll
                for (int bj = 0; bj < 2; ++bj)
#pragma unroll
                    for (int n = 0; n < 2; ++n) { const unsigned o = off + bj * 128 + n * 16; const f32x4 h = ld4bf(WSP(const bf16_t, WS_XN) + o) + acc[ai][bj][m][n] * rs; ss += sq4(h);
                        store4(WSP(bf16_t, WS_H1B) + o, h); }
                ss += __shfl_xor(ss, 16); ss += __shfl_xor(ss, 32);
                if (fq == 0) atomicAdd(WSP(float, OFF_SSQ_H1) + (unsigned)row, ss);
                asm volatile("" ::: "memory"); }
    }
};

struct EpiGU {
    static constexpr bool PERM = true, AFTER_DRAIN = false, MID = false;
    unsigned char* ws;
    __device__ __forceinline__ void operator()(const f32x4 (&acc)[2][2][4][2], const Unit& u, int wr, int wc, int fr_in, int fq_in) const {
        EPI_LANE();
        const int row0 = u.pm * 256 + wr * 64 + fr, col0 = u.pn * 128 + wc * 16 + 4 * fq;
#pragma unroll
        for (int ai = 0; ai < 2; ++ai)
#pragma unroll
            for (int m = 0; m < 4; ++m) { const int row = row0 + ai * 128 + m * 16; const float rs = rsq(WSP(const float, OFF_SSQ_H1)[(unsigned)row] * (1.f / 1024.f) + EPS);
#pragma unroll
                for (int bj = 0; bj < 2; ++bj) { const f32x4 g = acc[ai][bj][m][0] * rs, up = acc[ai][bj][m][1] * rs; f32x4 a;
#pragma unroll
                    for (int e = 0; e < 4; ++e) a[e] = g[e] * __builtin_amdgcn_rcpf(1.f + __builtin_amdgcn_exp2f(-1.4426950408889634f * g[e])) * up[e];
                    store4(WSP(bf16_t, WS_ACT) + (unsigned)(row * DFF + col0 + bj * 64), a); } }
    }
};

struct EpiDown {
    static constexpr bool PERM = false, AFTER_DRAIN = false, MID = false;
    float* h; unsigned char* ws;
    __device__ __forceinline__ void operator()(const f32x4 (&acc)[2][2][4][2], const Unit& u, int wr, int wc, int fr_in, int fq_in) const {
        EPI_LANE();
        const int row0 = u.pm * 256 + wr * 64 + fr, col0 = u.pn * 256 + wc * 32 + 4 * fq;
#pragma unroll
        for (int ai = 0; ai < 2; ++ai)
#pragma unroll
            for (int m = 0; m < 4; ++m) { const unsigned off = (unsigned)((row0 + ai * 128 + m * 16) * DM + col0);
#pragma unroll
                for (int bj = 0; bj < 2; ++bj)
#pragma unroll
                    for (int n = 0; n < 2; ++n) { const unsigned o = off + bj * 128 + n * 16; *(f32x4*)(h + o) = ld4bf(WSP(const bf16_t, WS_H1B) + o) + acc[ai][bj][m][n]; }
                asm volatile("" ::: "memory"); }
    }
};

struct EpiDownNorm {
    static constexpr bool PERM = false, AFTER_DRAIN = true, MID = false;
    float* h; const float* gfin; unsigned char* ws;
    __device__ __forceinline__ void fused(f32x4 (&acc)[2][2][4][2], const Unit& u, int wr, int wc, int fr_in, int fq_in, PG8_LAS unsigned char* lds, int wid, int lane) const {
        EPI_LANE();
        const int row0 = u.pm * 256 + wr * 64 + fr, col0 = u.pn * 256 + wc * 32 + 4 * fq;
        float* ssq = WSP(float, OFF_SSQ_H2);
#pragma unroll
        for (int ai = 0; ai < 2; ++ai)
#pragma unroll
            for (int m = 0; m < 4; ++m) { const int row = row0 + ai * 128 + m * 16; const unsigned off = (unsigned)(row * DM + col0); float ss = 0.f;
#pragma unroll
                for (int bj = 0; bj < 2; ++bj)
#pragma unroll
                    for (int n = 0; n < 2; ++n) { const unsigned o = off + bj * 128 + n * 16; acc[ai][bj][m][n] += ld4bf(WSP(const bf16_t, WS_H1B) + o); ss += sq4(acc[ai][bj][m][n]); }
                ss += __shfl_xor(ss, 16); ss += __shfl_xor(ss, 32);
                if (fq == 0) atomicAdd(ssq + (unsigned)row, ss);
                asm volatile("" ::: "memory"); }
        asm volatile("s_waitcnt vmcnt(0)" ::: "memory");
        __syncthreads();
        unsigned* cnt = WSP(unsigned, OFF_CNT) + 64 * u.pm;
        if (threadIdx.x == 0) {
            __hip_atomic_fetch_add(cnt, 1u, __ATOMIC_RELAXED, __HIP_MEMORY_SCOPE_AGENT);
            unsigned sp = 0;
            while (__hip_atomic_load(cnt, __ATOMIC_RELAXED, __HIP_MEMORY_SCOPE_AGENT) < 4u) { __builtin_amdgcn_s_sleep(2); if (++sp > (1u << 22)) break; }
            __builtin_amdgcn_fence(__ATOMIC_ACQUIRE, "agent");
        }
        __syncthreads();
#pragma unroll
        for (int ai = 0; ai < 2; ++ai)
#pragma unroll
            for (int m = 0; m < 4; ++m) { const int row = row0 + ai * 128 + m * 16; const unsigned off = (unsigned)(row * DM + col0);
                const float tot = __hip_atomic_load(ssq + (unsigned)row, __ATOMIC_RELAXED, __HIP_MEMORY_SCOPE_AGENT); const float rs = 1.0f / __builtin_sqrtf(tot * (1.f / DM) + EPS);
#pragma unroll
                for (int bj = 0; bj < 2; ++bj)
#pragma unroll
                    for (int n = 0; n < 2; ++n) { const unsigned o = off + bj * 128 + n * 16; const f32x4 g4 = *(const f32x4*)(gfin + (col0 + bj * 128 + n * 16)); *(f32x4*)(h + o) = (acc[ai][bj][m][n] * rs) * g4; }
                asm volatile("" ::: "memory"); }
    }
};

namespace att {
typedef LAS unsigned char lds_u8;
typedef float f32x16 __attribute__((ext_vector_type(16)));
typedef short s16x4 __attribute__((ext_vector_type(4)));
typedef short v4i16_t __attribute__((ext_vector_type(4)));
constexpr int KBUF = 12288, VBUF = 8192;
constexpr int KSLOTS = 4, VSLOTS = 4;
constexpr int L_K = 0, L_V = KSLOTS * KBUF, L_WSF = L_V + VSLOTS * VBUF, L_STG = L_WSF + 2048, L_FLAG = L_STG + 8 * 4096, L_UNIT = L_FLAG + 64, L_END = L_UNIT + 16;
static_assert(L_END <= 131072, "attention LDS map");
constexpr int ML_K = L_K, ML_V = L_V;
#define MFMA32(a, b, c) __builtin_amdgcn_mfma_f32_32x32x16_bf16((a), (b), (c), 0, 0, 0)
__device__ __forceinline__ s16x4 vtr(lds_u8* p) { return __builtin_bit_cast(s16x4, __builtin_amdgcn_ds_read_tr16_b64_v4i16((LAS v4i16_t*)p)); }
__device__ __forceinline__ bf16x8 pk8(const f32x16& p, int b) { u32x4 w; w.x = cvtpk(p[b], p[b + 1]); w.y = cvtpk(p[b + 2], p[b + 3]); w.z = cvtpk(p[b + 4], p[b + 5]); w.w = cvtpk(p[b + 6], p[b + 7]); return __builtin_bit_cast(bf16x8, w); }
__device__ __forceinline__ float ex2(float x) { return __builtin_amdgcn_exp2f(x); }
__device__ __forceinline__ float lg2(float x) { return __builtin_amdgcn_logf(x); }


template <int ND> __device__ __forceinline__ void qk_tile(f32x16& p0, f32x16& p1, lds_u8* kp, const bf16x8 (&qr)[ND]) {
#pragma unroll
    for (int d0 = 0; d0 < ND; ++d0) {
        const bf16x8 b0 = *(LAS bf16x8*)(kp + d0 * 2048), b1 = *(LAS bf16x8*)(kp + d0 * 2048 + 512);
        p0 = MFMA32(b0, qr[d0], p0); p1 = MFMA32(b1, qr[d0], p1); }
}
__device__ __forceinline__ void pv_tile(f32x16 (&o)[2], lds_u8* vp, const f32x16& p0, const f32x16& p1) {
    const bf16x8 pa0 = pk8(p0, 0), pa1 = pk8(p0, 8), pa2 = pk8(p1, 0), pa3 = pk8(p1, 8);
#pragma unroll
    for (int d0 = 0; d0 < 2; ++d0) {
        s16x4 lo[4], hh[4];
#pragma unroll
        for (int ks = 0; ks < 4; ++ks) { lo[ks] = vtr(vp + d0 * 4096 + ks * 1024); hh[ks] = vtr(vp + d0 * 4096 + ks * 1024 + 512); }
#define VF(k) (bf16x8){lo[k][0], lo[k][1], lo[k][2], lo[k][3], hh[k][0], hh[k][1], hh[k][2], hh[k][3]}
        o[d0] = MFMA32(pa0, VF(0), o[d0]); o[d0] = MFMA32(pa1, VF(1), o[d0]); o[d0] = MFMA32(pa2, VF(2), o[d0]); o[d0] = MFMA32(pa3, VF(3), o[d0]);
#undef VF
    }
}
__device__ __forceinline__ void pv_tile4(f32x16 (&o)[2], lds_u8* vp, bf16x8 pa0, bf16x8 pa1, bf16x8 pa2, bf16x8 pa3) {
#pragma unroll
    for (int d0 = 0; d0 < 2; ++d0) {
        s16x4 lo[4], hh[4];
#pragma unroll
        for (int ks = 0; ks < 4; ++ks) { lo[ks] = vtr(vp + d0 * 4096 + ks * 1024); hh[ks] = vtr(vp + d0 * 4096 + ks * 1024 + 512); }
#define VF(k) (bf16x8){lo[k][0], lo[k][1], lo[k][2], lo[k][3], hh[k][0], hh[k][1], hh[k][2], hh[k][3]}
        o[d0] = MFMA32(pa0, VF(0), o[d0]); o[d0] = MFMA32(pa1, VF(1), o[d0]); o[d0] = MFMA32(pa2, VF(2), o[d0]); o[d0] = MFMA32(pa3, VF(3), o[d0]);
#undef VF
    }
}
template <int ND> __device__ __forceinline__ void qk_tile_c(f32x16& p0, f32x16& p1, lds_u8* kp, const bf16x8 (&qr)[ND], const f32x16& cinit) {
#pragma unroll
    for (int d0 = 0; d0 < ND; ++d0) {
        const bf16x8 b0 = *(LAS bf16x8*)(kp + d0 * 2048), b1 = *(LAS bf16x8*)(kp + d0 * 2048 + 512);
        if (d0 == 0) { p0 = MFMA32(b0, qr[0], cinit); p1 = MFMA32(b1, qr[0], cinit); }
        else { p0 = MFMA32(b0, qr[d0], p0); p1 = MFMA32(b1, qr[d0], p1); }
    }
}
__device__ __forceinline__ float max3f(float a, float b, float c) { float r; asm("v_max3_f32 %0, %1, %2, %3" : "=v"(r) : "v"(a), "v"(b), "v"(c)); return r; }
__device__ __forceinline__ float rowmax32(const f32x16& p0, const f32x16& p1) {
    float a, b;
    asm volatile("s_nop 15\n\ts_nop 7\n\tv_max3_f32 %0, %2, %3, %4\n\tv_max3_f32 %1, %5, %6, %7" : "=&v"(a), "=&v"(b) : "v"(p0[0]), "v"(p0[1]), "v"(p1[0]), "v"(p0[2]), "v"(p0[3]), "v"(p1[1]));
    a = max3f(a, p1[2], p1[3]);
#pragma unroll
    for (int r = 4; r < 16; r += 4) { a = max3f(a, p0[r], p0[r + 1]); b = max3f(b, p0[r + 2], p0[r + 3]); a = max3f(a, p1[r], p1[r + 1]); b = max3f(b, p1[r + 2], p1[r + 3]); }
    return max3f(a, b, b);
}
__device__ __forceinline__ void pv_tile5(f32x16 (&o)[3], lds_u8* vp, bf16x8 pa0, bf16x8 pa1, bf16x8 pa2, bf16x8 pa3, bf16x8 ones) {
#pragma unroll
    for (int d0 = 0; d0 < 2; ++d0) {
        s16x4 lo[4], hh[4];
#pragma unroll
        for (int ks = 0; ks < 4; ++ks) { lo[ks] = vtr(vp + d0 * 4096 + ks * 1024); hh[ks] = vtr(vp + d0 * 4096 + ks * 1024 + 512); }
#define VF(k) (bf16x8){lo[k][0], lo[k][1], lo[k][2], lo[k][3], hh[k][0], hh[k][1], hh[k][2], hh[k][3]}
        o[d0] = MFMA32(pa0, VF(0), o[d0]); o[d0] = MFMA32(pa1, VF(1), o[d0]); o[d0] = MFMA32(pa2, VF(2), o[d0]); o[d0] = MFMA32(pa3, VF(3), o[d0]);
#undef VF
    }
    o[2] = MFMA32(pa0, ones, o[2]); o[2] = MFMA32(pa1, ones, o[2]); o[2] = MFMA32(pa2, ones, o[2]); o[2] = MFMA32(pa3, ones, o[2]);
}
template <int NO> __device__ __forceinline__ void store_o(lds_u8* lds, unsigned char* ws, const f32x16 (&o)[NO], const float (&rli)[16], size_t rowbase, int q0, int wid, int lane, int r32, int hi, int col0, int h, size_t ssq_off) {
    LAS bf16_t* stg = (LAS bf16_t*)(lds + L_STG) + wid * 2048;
#pragma unroll
    for (int r = 0; r < 16; ++r) { const int orow = (r & 3) + 8 * (r >> 2) + 4 * hi;
#pragma unroll
        for (int d0 = 0; d0 < 2; ++d0) stg[orow * 64 + d0 * 32 + r32] = (bf16_t)(cvtpk(o[d0][r] * rli[r], 0.f) & 0xffffu); }
    asm volatile("s_waitcnt lgkmcnt(0)" ::: "memory");
    bf16_t* Ow = WSP(bf16_t, WS_OMIX) + (rowbase + q0 + wid * 32) * 1024 + col0 + h * 64;
    float* ssq = (float*)(ws + ssq_off) + rowbase + q0 + wid * 32;
#pragma unroll
    for (int i = 0; i < 4; ++i) { const int row = i * 8 + (lane >> 3), ch = lane & 7; const u32x4 v = *(LAS u32x4*)(stg + row * 64 + ch * 8);
        float ss = 0.f;
#pragma unroll
        for (int e = 0; e < 4; ++e) { const float a = __uint_as_float(v[e] << 16), bb = __uint_as_float(v[e] & 0xffff0000u); ss += a * a + bb * bb; }
        ss += __shfl_xor(ss, 1); ss += __shfl_xor(ss, 2); ss += __shfl_xor(ss, 4);
        if (ch == 0) atomicAdd(ssq + row, ss);
        *(u32x4*)(Ow + (unsigned)(row * 1024 + ch * 8)) = v; }
}
__device__ __forceinline__ float max16(const f32x16& p) {
    float a = fmaxf(fmaxf(p[0], p[1]), fmaxf(p[2], p[3])), b = fmaxf(fmaxf(p[4], p[5]), fmaxf(p[6], p[7]));
    float c = fmaxf(fmaxf(p[8], p[9]), fmaxf(p[10], p[11])), d = fmaxf(fmaxf(p[12], p[13]), fmaxf(p[14], p[15]));
    return fmaxf(fmaxf(a, b), fmaxf(c, d));
}
__device__ __forceinline__ float sum16(const f32x16& p) {
    return (((p[0] + p[1]) + (p[2] + p[3])) + ((p[4] + p[5]) + (p[6] + p[7]))) + (((p[8] + p[9]) + (p[10] + p[11])) + ((p[12] + p[13]) + (p[14] + p[15])));
}

__device__ __forceinline__ void sb_half(f32x16& p, float& C, int hi, bool diag, int kvb, int qrel) {
    float R[16];
#pragma unroll
    for (int r = 0; r < 16; ++r) { const float e = ex2(__builtin_amdgcn_fmed3f(p[r], -126.f, 126.f)); const float rr = __builtin_amdgcn_rcpf(1.f + e); R[r] = rr; p[r] = e * rr; }
    if (diag) {
#pragma unroll
        for (int r = 0; r < 16; ++r) { const int kv = kvb + (r & 3) + 8 * (r >> 2); if (kv >= qrel) { R[r] = 1.f; p[r] = 0.f; } }
    }
    float G[4], Gp[4], E[4];
#pragma unroll
    for (int g = 0; g < 4; ++g) { G[g] = (R[4 * g] * R[4 * g + 1]) * (R[4 * g + 2] * R[4 * g + 3]); Gp[g] = __shfl_xor(G[g], 32); }
    float acc = C;
#pragma unroll
    for (int g = 3; g >= 0; --g) { E[g] = acc * (hi == 0 ? Gp[g] : 1.f); acc *= G[g] * Gp[g]; }
    C = acc;
#pragma unroll
    for (int g = 0; g < 4; ++g) {
        float s = E[g];
#pragma unroll
        for (int i = 3; i >= 0; --i) { const int r = 4 * g + i; p[r] *= s; s *= R[r]; }
    }
}
__device__ __forceinline__ void sb_transform(f32x16& p0, f32x16& p1, float& c, int hi, bool diag, int kvb, int qrel) {
    sb_half(p1, c, hi, diag, kvb + 32, qrel);
    __builtin_amdgcn_sched_barrier(0);
    sb_half(p0, c, hi, diag, kvb, qrel);
}


__device__ __forceinline__ void glds16(const void* gsrc, unsigned lds_dst) { unsigned keep;
    asm volatile("s_mov_b32 %0, m0\n\ts_mov_b32 m0, %2\n\ts_nop 0\n\tglobal_load_lds_dwordx4 %1, off\n\ts_mov_b32 m0, %0" : "=&s"(keep) : "v"(gsrc), "s"(lds_dst) : "memory"); }
__device__ __forceinline__ void mla_unit(lds_u8* lds, unsigned char* ws, int b, int h, int qb) {
    const int tid = threadIdx.x, lane = tid & 63, r32 = lane & 31, hi = lane >> 5; const int wid = __builtin_amdgcn_readfirstlane(tid >> 6);
    const size_t rowbase = (size_t)b * SEQ; const int q0 = qb * 256;
    const bf16_t* Qb = WSP(const bf16_t, WS_QMLA) + (rowbase + q0) * 768 + h * 96;
    const char* Kb = (const char*)(WSP(const bf16_t, WS_KVMLA) + rowbase * 1024 + h * 128);
    const char* Vb = Kb + 128;
    const char* KRb = (const char*)(WSP(const bf16_t, WS_KR) + rowbase * 32);
    const unsigned koff = (unsigned)(lane * 1024 + wid * 8) * 2u, kroff = (unsigned)(lane * 32 + (wid & 3) * 8) * 2u,
                   voff = (unsigned)((16 * (wid & 3) + (lane >> 2)) * 1024 + (wid >> 2) * 32 + (lane & 3) * 8) * 2u;
#define DMA16(src, dst) glds16((src), (unsigned)__builtin_amdgcn_readfirstlane((int)(unsigned)(uintptr_t)(dst)))
#define DMA_K(t, slot) do { DMA16(Kb + (koff + (unsigned)(t) * (64u * 2048u)), lds + L_K + (slot) * KBUF + wid * 1024); \
        if (wid < 4) DMA16(KRb + (kroff + (unsigned)(t) * (64u * 64u)), lds + L_K + (slot) * KBUF + (8 + wid) * 1024); } while (0)
#define DMA_V(t, slot) DMA16(Vb + (voff + (unsigned)(t) * (64u * 2048u)), lds + L_V + (slot) * VBUF + wid * 1024)
#define WAIT_SYNC() do { asm volatile("s_waitcnt vmcnt(0)" ::: "memory"); __syncthreads(); } while (0)
#define WAIT_SYNC_AHEAD() do { if (wid < 4) asm volatile("s_waitcnt vmcnt(3)" ::: "memory"); else asm volatile("s_waitcnt vmcnt(2)" ::: "memory"); __syncthreads(); } while (0)
    const int NT = 4 * (qb + 1);
    const int Tw = min(NT, NT - 3 + (wid >> 1));
    DMA_K(0, 0); DMA_K(1, 1); DMA_V(0, 0);
    bf16x8 qr[6];
#pragma unroll
    for (int d0 = 0; d0 < 6; ++d0) qr[d0] = *(const bf16x8*)(Qb + (unsigned)((wid * 32 + r32) * 768 + d0 * 16 + hi * 8));
    WAIT_SYNC();
    lds_u8* kp0 = lds + L_K + hi * 1024 + r32 * 16;
    lds_u8* vp0 = lds + L_V + ((lane >> 4) & 1) * 32 + (lane & 3) * 8 + (4 * hi + ((lane & 15) >> 2)) * 64;
    LAS float* wsf = (LAS float*)(lds + L_WSF) + wid * 64;
    const int qrel = 32 * wid + r32;
    f32x16 o[3], negm, P0, P1;
#pragma unroll
    for (int r = 0; r < 16; ++r) { o[0][r] = 0.f; o[1][r] = 0.f; o[2][r] = 0.f; }
    const bf16x8 ones = {0x3F80, 0x3F80, 0x3F80, 0x3F80, 0x3F80, 0x3F80, 0x3F80, 0x3F80};
    float m_ref;
    DMA_K(2, 2); DMA_V(1, 1);
    {
        f32x16 S0, S1;
#pragma unroll
        for (int r = 0; r < 16; ++r) { S0[r] = 0.f; S1[r] = 0.f; }
        qk_tile<6>(S0, S1, kp0, qr);
        if (NT == 4) { const int thr = qrel - 4 * hi;
#pragma unroll
            for (int r = 0; r < 16; ++r) { const int kc = (r & 3) + 8 * (r >> 2); if (kc > thr) S0[r] = -INFINITY; if (kc + 32 > thr) S1[r] = -INFINITY; } }
        float rm = fmaxf(max16(S0), max16(S1)); rm = fmaxf(rm, __shfl_xor(rm, 32));
        m_ref = rm;
#pragma unroll
        for (int r = 0; r < 16; ++r) { P0[r] = ex2(S0[r] - rm); P1[r] = ex2(S1[r] - rm); negm[r] = -rm; }
    }
    WAIT_SYNC_AHEAD();
    for (int t = 1; t < NT; ++t) {
        const bool ahead = (t + 2 < NT);
        if (ahead) { DMA_K(t + 2, (t + 2) & 3); DMA_V(t + 1, (t + 1) & 3); } else if (t + 1 < NT) DMA_V(t + 1, (t + 1) & 3);
        if (t < Tw) {
            f32x16 S0, S1;
            qk_tile_c<6>(S0, S1, kp0 + (t & 3) * KBUF, qr, negm);
            __builtin_amdgcn_iglp_opt(0);
            const bf16x8 pa0 = pk8(P0, 0), pa1 = pk8(P0, 8), pa2 = pk8(P1, 0), pa3 = pk8(P1, 8);
            const int jb = t - (NT - 4);
            if (jb >= 0) { const int thr = qrel - 64 * jb - 4 * hi;
#pragma unroll
                for (int r = 0; r < 16; ++r) { const int kc = (r & 3) + 8 * (r >> 2); if (kc > thr) S0[r] = -INFINITY; if (kc + 32 > thr) S1[r] = -INFINITY; } }
            float rm = rowmax32(S0, S1); rm = fmaxf(rm, __shfl_xor(rm, 32));
            bool resc = false;
            if (__any(rm > 8.0f)) {
                const float dl = fmaxf(rm, 0.f); m_ref += dl;
#pragma unroll
                for (int r = 0; r < 16; ++r) { S0[r] -= dl; S1[r] -= dl; negm[r] = -m_ref; }
                const float f = ex2(-dl); if (hi == 0) wsf[r32] = f; resc = true;
            }
            __builtin_amdgcn_iglp_opt(0);
            pv_tile5(o, vp0 + ((t - 1) & 3) * VBUF, pa0, pa1, pa2, pa3, ones);
#pragma unroll
            for (int r = 0; r < 16; ++r) { P0[r] = ex2(S0[r]); P1[r] = ex2(S1[r]); }
            if (resc) {
#pragma unroll
                for (int r = 0; r < 16; ++r) { const float fr_ = wsf[(r & 3) + 8 * (r >> 2) + 4 * hi]; o[0][r] *= fr_; o[1][r] *= fr_; o[2][r] *= fr_; }
            }
        } else if (t == Tw) {
            pv_tile5(o, vp0 + ((t - 1) & 3) * VBUF, pk8(P0, 0), pk8(P0, 8), pk8(P1, 0), pk8(P1, 8), ones);
        }
        if (ahead) WAIT_SYNC_AHEAD(); else WAIT_SYNC();
    }
    if (Tw == NT) pv_tile5(o, vp0 + ((NT - 1) & 3) * VBUF, pk8(P0, 0), pk8(P0, 8), pk8(P1, 0), pk8(P1, 8), ones);
    float rli[16];
#pragma unroll
    for (int r = 0; r < 16; ++r) rli[r] = __builtin_amdgcn_rcpf(o[2][r]);
    store_o(lds, ws, o, rli, rowbase, q0, wid, lane, r32, hi, 0, h, OFF_SSQ_MLA);
    __syncthreads();
#undef DMA16
#undef DMA_K
#undef DMA_V
#undef WAIT_SYNC
#undef WAIT_SYNC_AHEAD
}

constexpr int SBW = 7, SB_K = 0, SB_V = SBW * 8192;
static_assert(SB_V + SBW * 8192 <= L_FLAG, "SB window");
__device__ __forceinline__ void sb_unit(lds_u8* lds, unsigned char* ws, int b, int h, int qb) {
    const int tid = threadIdx.x, lane = tid & 63, r32 = lane & 31, hi = lane >> 5; const int wid = __builtin_amdgcn_readfirstlane(tid >> 6);
    const size_t rowbase = (size_t)b * SEQ; const int q0 = qb * 256;
    const bf16_t* Qb = WSP(const bf16_t, WS_QSB) + (rowbase + q0) * 512 + h * 64;
    const char* Kb = (const char*)(WSP(const bf16_t, WS_KSB) + rowbase * 512 + h * 64);
    const char* Vb = (const char*)(WSP(const bf16_t, WS_VSB) + rowbase * 512 + h * 64);
    const unsigned koff = (unsigned)(lane * 512 + wid * 8) * 2u, voff = (unsigned)((16 * (wid & 3) + (lane >> 2)) * 512 + (wid >> 2) * 32 + (lane & 3) * 8) * 2u;
#define SB_DMA(t, slot) do { glds16(Kb + (koff + (unsigned)(t) * (64u * 1024u)), (unsigned)__builtin_amdgcn_readfirstlane((int)(unsigned)(uintptr_t)(lds + SB_K + (slot) * 8192 + wid * 1024))); \
        glds16(Vb + (voff + (unsigned)(t) * (64u * 1024u)), (unsigned)__builtin_amdgcn_readfirstlane((int)(unsigned)(uintptr_t)(lds + SB_V + (slot) * 8192 + wid * 1024))); } while (0)
    const int NT = 4 * (qb + 1);
    const int W = (NT < SBW) ? NT : SBW;
    for (int i = 0; i < W; ++i) SB_DMA(NT - 1 - i, i);
    bf16x8 qr[4];
#pragma unroll
    for (int d0 = 0; d0 < 4; ++d0) qr[d0] = *(const bf16x8*)(Qb + (unsigned)((wid * 32 + r32) * 512 + d0 * 16 + hi * 8));
    asm volatile("s_waitcnt vmcnt(0)" ::: "memory"); __syncthreads();
    lds_u8* kp0 = lds + SB_K + hi * 1024 + r32 * 16;
    lds_u8* vp0 = lds + SB_V + ((lane >> 4) & 1) * 32 + (lane & 3) * 8 + (4 * hi + ((lane & 15) >> 2)) * 64;
    f32x16 o[2];
#pragma unroll
    for (int r = 0; r < 16; ++r) { o[0][r] = 0.f; o[1][r] = 0.f; }
    const int qrel = 32 * wid + r32;
    float c = 1.f; bool wdone = false;
    for (int i = 3 - (wid >> 1); i < W && !wdone; ++i) {
        const int jb = 3 - i;
        f32x16 p0, p1;
#pragma unroll
        for (int r = 0; r < 16; ++r) { p0[r] = 0.f; p1[r] = 0.f; }
        qk_tile<4>(p0, p1, kp0 + i * 8192, qr);
        sb_transform(p0, p1, c, hi, jb >= 0, 64 * jb + 4 * hi, qrel);
        pv_tile(o, vp0 + i * 8192, p0, p1);
        wdone = __all(c == 0.f);
    }
    LAS int* flags = (LAS int*)(lds + L_FLAG);
    if (lane == 0) flags[wid] = wdone ? 1 : 0;
    __syncthreads();
    int alld = 1;
#pragma unroll
    for (int w = 0; w < 8; ++w) alld &= flags[w];
    for (int t = NT - 1 - W; t >= 0 && !alld; --t) {
        SB_DMA(t, 0);
        asm volatile("s_waitcnt vmcnt(0)" ::: "memory"); __syncthreads();
        if (!wdone) {
            f32x16 p0, p1;
#pragma unroll
            for (int r = 0; r < 16; ++r) { p0[r] = 0.f; p1[r] = 0.f; }
            qk_tile<4>(p0, p1, kp0, qr);
            sb_transform(p0, p1, c, hi, false, 0, qrel);
            pv_tile(o, vp0, p0, p1);
            wdone = __all(c == 0.f);
        }
        if (lane == 0) flags[8 + wid] = wdone ? 1 : 0;
        __syncthreads();
        alld = 1;
#pragma unroll
        for (int w = 0; w < 8; ++w) alld &= flags[8 + w];
    }
    float rli[16];
#pragma unroll
    for (int r = 0; r < 16; ++r) rli[r] = 1.f;
    store_o(lds, ws, o, rli, rowbase, q0, wid, lane, r32, hi, 512, h, OFF_SSQ_SB);
    __syncthreads();
#undef SB_DMA
}

__device__ __forceinline__ int attn_phase(lds_u8* lds, unsigned char* ws) {
    for (;;) {
        if (threadIdx.x == 0) *(LAS unsigned*)(lds + L_UNIT) = atomicAdd(WSP(unsigned, OFF_CTR), 1u);
        __syncthreads();
        const int idx = __builtin_amdgcn_readfirstlane((int)*(LAS unsigned*)(lds + L_UNIT));
        __syncthreads();
        if (idx >= 1024) return idx;
        const int i2 = idx & 511, qb = 31 - (i2 >> 4), bh = i2 & 15;
#if !defined(ATT_ONLY) || ATT_ONLY == 0
        if (idx < 512) mla_unit(lds, ws, bh >> 3, bh & 7, qb);
#endif
#if !defined(ATT_ONLY) || ATT_ONLY == 1
        if (idx >= 512) sb_unit(lds, ws, bh >> 3, bh & 7, qb);
#endif
    }
}
}


constexpr int LDSCTL_OFF = 131072;
constexpr int LDS_BYTES = 147456;
constexpr int NWAVES = 8;

__device__ __forceinline__ float wave_sum(float v) {
#pragma unroll
    for (int o = 1; o < 64; o <<= 1) v += __shfl_xor(v, o);
    return v;
}
#define LDS_WAIT() asm volatile("s_waitcnt lgkmcnt(0)" ::: "memory")
__device__ __forceinline__ void tr_item(const float* W, int ldw, int k0, int n0, const float* gk, bf16_t* WT, int ldt, int drow0, int dcol0, bool il, LAS float* scr, int lane) {
    const int ks = lane >> 3, n4 = lane & 7;
    f32x4 w[8];
#pragma unroll
    for (int i = 0; i < 8; ++i) w[i] = *(const f32x4*)(W + (size_t)(k0 + 8 * i + ks) * ldw + n0 + 4 * n4);
#pragma unroll
    for (int i = 0; i < 8; ++i) { const int kk = 8 * i + ks; const float g = gk ? gk[kk] : 1.f; LAS float* s = scr + kk * 33 + 4 * n4;
        s[0] = w[i][0] * g; s[1] = w[i][1] * g; s[2] = w[i][2] * g; s[3] = w[i][3] * g; }
    LDS_WAIT();
    const int c = lane & 7;
#pragma unroll
    for (int j = 0; j < 4; ++j) { const int n = (lane >> 3) + 8 * j; const LAS float* s = scr + (8 * c) * 33 + n;
        u32x4 o; o.x = cvtpk(s[0 * 33], s[1 * 33]); o.y = cvtpk(s[2 * 33], s[3 * 33]); o.z = cvtpk(s[4 * 33], s[5 * 33]); o.w = cvtpk(s[6 * 33], s[7 * 33]);
        const int drow = drow0 + (il ? (8 * (n >> 2) + (n & 3)) : n);
        *(u32x4*)(WT + (size_t)drow * ldt + dcol0 + 8 * c) = o; }
    LDS_WAIT();
}

#define XB_TMO      128
#define XB_XCNT(j)  (256  + 64 * (j))
#define XB_XSUB(j)  (1280 + 64 * (j))
#define XB_XGEN(j)  (2304 + 64 * (j))
#define XB_TOP      3328
#define XB_TOPGEN   3392
#define XCD_BAR_WORDS 3456
#define XB_SPIN_CAP (1u << 18)

__device__ __forceinline__ unsigned xb_ld(unsigned* p)              { return __hip_atomic_load(p, __ATOMIC_RELAXED, __HIP_MEMORY_SCOPE_AGENT); }
__device__ __forceinline__ unsigned xb_add(unsigned* p, unsigned v) { return __hip_atomic_fetch_add(p, v, __ATOMIC_RELAXED, __HIP_MEMORY_SCOPE_AGENT); }
__device__ __forceinline__ unsigned xb_xcc_id() { return (unsigned)__builtin_amdgcn_s_getreg((3 << 11) | 20) & 0xFu; }
#define XB_SPIN(cond, bar) do { unsigned _sp = 0; while (cond) { __builtin_amdgcn_s_sleep(1); \
    if ((++_sp & 255u) == 0u) { if (xb_ld(&(bar)[XB_TMO])) break; if (_sp > XB_SPIN_CAP) { atomicAdd(&(bar)[XB_TMO], 1u); break; } } } } while (0)

struct XcdBarrier {
    unsigned* bar; unsigned x;
    volatile LAS unsigned* st;
};

__device__ __forceinline__ XcdBarrier xcd_barrier_post(unsigned* bar, volatile LAS unsigned* st) {
    XcdBarrier b; b.bar = bar; b.x = xb_xcc_id(); b.st = st;
    if (threadIdx.x == 0) (void)xb_add(&bar[XB_XCNT(b.x)], 1u);
    return b;
}
__device__ __forceinline__ void xcd_barrier_complete(unsigned* bar, unsigned x, unsigned& nloc, unsigned& nx) {
    const unsigned G = gridDim.x * gridDim.y * gridDim.z;
    unsigned sum, cnt, mine, sp = 0u;
    for (;;) {
        sum = 0u; cnt = 0u; mine = 0u;
#pragma unroll
        for (unsigned j = 0; j < 16; ++j) { const unsigned c = xb_ld(&bar[XB_XCNT(j)]); sum += c; cnt += (c > 0u) ? 1u : 0u; mine = (j == x) ? c : mine; }
        if (sum == G) break;
        __builtin_amdgcn_s_sleep(1);
        if ((++sp & 255u) == 0u) { if (xb_ld(&bar[XB_TMO])) break; if (sp > XB_SPIN_CAP) { atomicAdd(&bar[XB_TMO], 1u); break; } }
    }
    nloc = mine > 0u ? mine : 1u; nx = cnt > 0u ? cnt : 1u;
}

__device__ __forceinline__ void xcd_barrier(const XcdBarrier& b) {
    asm volatile("s_waitcnt vmcnt(0)" ::: "memory");
    __syncthreads();
    if (threadIdx.x == 0) {
        unsigned* bar = b.bar;
        __builtin_amdgcn_s_waitcnt(0);
        unsigned nloc = b.st[0], nx = b.st[1];
        if (nloc == 0u) { xcd_barrier_complete(bar, b.x, nloc, nx); b.st[0] = nloc; b.st[1] = nx; }
        const unsigned old = xb_add(&bar[XB_XSUB(b.x)], 1u);
        const unsigned gen = old / nloc;
        if (old + 1u == (gen + 1u) * nloc) {
            __builtin_amdgcn_fence(__ATOMIC_RELEASE, "agent");
            asm volatile("s_waitcnt vmcnt(0)" ::: "memory");
            const unsigned og = xb_add(&bar[XB_TOP], 1u);
            const unsigned tg = og / nx;
            if (og + 1u == (tg + 1u) * nx) xb_add(&bar[XB_TOPGEN], 1u);
            else XB_SPIN(xb_ld(&bar[XB_TOPGEN]) == tg, bar);
            __builtin_amdgcn_fence(__ATOMIC_ACQUIRE, "agent");
            xb_add(&bar[XB_XGEN(b.x)], 1u);
            asm volatile("s_waitcnt vmcnt(0)" ::: "memory");
        } else {
            XB_SPIN(xb_ld(&bar[XB_XGEN(b.x)]) == gen, bar);
            __builtin_amdgcn_fence(__ATOMIC_ACQUIRE, "agent");
            asm volatile("s_waitcnt vmcnt(0)" ::: "memory");
        }
    }
    __syncthreads();
}

#define CONV_ITEMS(lo, hi, first, stride) do { \
    LAS float* scr_ = (LAS float*)(lds + wave * 16384); \
    constexpr int J1 = 16 * 61, J2 = 4 * 24, J3 = 2 * 32, J4 = 16 * 32, J5 = 16 * 88, J6 = 16 * 88; \
    for (int it_ = (lo) + (first); it_ < (hi); it_ += (stride)) { int r = it_; \
        if (r < J1) { const int kb = r / 61, nb = r % 61, n0 = 32 * nb; tr_item(w_in, 1952, 64 * kb, n0, norm_mix + 64 * kb, WIN, 1024, n0 + (n0 >= 416 ? 96 : 0), 64 * kb, false, scr_, lane); continue; } r -= J1; \
        if (r < J2) { const int kb = r / 24, nb = r % 24; tr_item(w_uq, 768, 64 * kb, 32 * nb, qln + 64 * kb, WUP, 256, 32 * nb, 64 * kb, false, scr_, lane); continue; } r -= J2; \
        if (r < J3) { const int kb = r / 32, nb = r % 32; tr_item(w_ukv, 1024, 64 * kb, 32 * nb, kvln + 64 * kb, WUP + 768 * 256, 128, 32 * nb, 64 * kb, false, scr_, lane); continue; } r -= J3; \
        if (r < J4) { const int kb = r / 32, nb = r % 32; tr_item(w_o, 1024, 64 * kb, 32 * nb, (kb < 8 ? on_mla + 64 * kb : on_sb + 64 * (kb - 8)), WO, 1024, 32 * nb, 64 * kb, false, scr_, lane); continue; } r -= J4; \
        if (r < J5) { const int kb = r / 88, nb = r % 88; tr_item(w_gate, DFF, 64 * kb, 32 * nb, norm_ffn + 64 * kb, WGU, 1024, 64 * nb, 64 * kb, true, scr_, lane); continue; } r -= J5; \
        if (r < J6) { const int kb = r / 88, nb = r % 88; tr_item(w_up, DFF, 64 * kb, 32 * nb, norm_ffn + 64 * kb, WGU, 1024, 64 * nb + 4, 64 * kb, true, scr_, lane); continue; } r -= J6; \
        { const int kb = r / 32, nb = r % 32; tr_item(w_down, 1024, 64 * kb, 32 * nb, nullptr, WD, DFF, 32 * nb, 64 * kb, false, scr_, lane); } } } while (0)
#define CONV_BY_IDLE(nwg, lo, hi) do { const int rem_ = (nwg) % G, fi_ = rem_ ? rem_ : 0, ni_ = rem_ ? G - rem_ : G; \
    if ((int)blockIdx.x >= fi_) CONV_ITEMS(lo, hi, ((int)blockIdx.x - fi_) * NWAVES + wave, ni_ * NWAVES); } while (0)

struct Args { const float* in[16]; float* out; unsigned char* ws; };

__global__ void __launch_bounds__(NWAVES * 64, 2) mk_fwd(Args a) {
    extern __shared__ __attribute__((aligned(16))) unsigned char lds_raw[];
    LAS unsigned char* lds = (LAS unsigned char*)lds_raw;
    cg::grid_group grid = cg::this_grid();
    const int tid = threadIdx.x, lane = tid & 63; const int wave = __builtin_amdgcn_readfirstlane(tid >> 6);
    const int G = gridDim.x;
    unsigned char* ws = a.ws;
    for (int u = tid; u < (LDS_BYTES - LDSCTL_OFF) / 4; u += NWAVES * 64) ((LAS unsigned*)(lds + LDSCTL_OFF))[u] = 0u;
    __syncthreads();
    const XcdBarrier bar = xcd_barrier_post((unsigned*)(ws + OFF_BAR), (volatile LAS unsigned*)(lds + LDSCTL_OFF + 352));
    const float* x = a.in[0]; const int* positions = (const int*)a.in[1];
    const float *norm_mix = a.in[2], *w_in = a.in[3], *qln = a.in[4], *w_uq = a.in[5], *kvln = a.in[6], *w_ukv = a.in[7], *on_mla = a.in[8], *on_sb = a.in[9],
                *w_o = a.in[10], *norm_ffn = a.in[11], *w_gate = a.in[12], *w_up = a.in[13], *w_down = a.in[14], *norm_final = a.in[15];
    float* out = a.out;
    bf16_t *WIN = (bf16_t*)(ws + WS_WIN), *WUP = (bf16_t*)(ws + WS_WUP), *WO = (bf16_t*)(ws + WS_WO), *WGU = (bf16_t*)(ws + WS_WGU), *WD = (bf16_t*)(ws + WS_WD);
    float2* CS = (float2*)(ws + WS_CS);
    bf16_t *XN = (bf16_t*)(ws + WS_XN), *H1B = (bf16_t*)(ws + WS_H1B), *CQKV = (bf16_t*)(ws + WS_CQKV), *OMIX = (bf16_t*)(ws + WS_OMIX), *ACT = (bf16_t*)(ws + WS_ACT);

    {
        const int gw = blockIdx.x * NWAVES + wave, NGW = G * NWAVES;
        constexpr int I1 = 16 * 61, I2 = 4 * 24, I3 = 2 * 32, I4 = 16 * 32, I5 = 16 * 88, I6 = 16 * 88, I7 = 44 * 32;
        CONV_ITEMS(0, I1 + I2 + I3, gw, NGW);
        const int gt = blockIdx.x * (NWAVES * 64) + tid, NGT = G * NWAVES * 64; const u32x4 z4 = {0u, 0u, 0u, 0u};
        for (int i = gt; i < 96 * 128; i += NGT) *(u32x4*)(WIN + (size_t)416 * 1024 + (size_t)i * 8) = z4;
        for (int i = gt; i < M * 16; i += NGT) { const int row = i >> 4, k = i & 15; const float inv = __builtin_amdgcn_exp2f(-(float)k * 0.8304820237218405f); const float ang = (float)positions[row] * inv;
            double tr = (double)ang * 0.15915494309189535; tr -= __builtin_floor(tr); const float fr_ = (float)tr;
            CS[i] = make_float2(__builtin_amdgcn_cosf(fr_), __builtin_amdgcn_sinf(fr_)); }
        for (int m = 4 * gw; m < M; m += 4 * NGW) {
            const f32x4* xr = (const f32x4*)(x + (size_t)m * DM) + lane;
            f32x4 v[4][4];
#pragma unroll
            for (int r = 0; r < 4; ++r)
#pragma unroll
                for (int j = 0; j < 4; ++j) v[r][j] = xr[256 * r + 64 * j];
            u32x2* o8 = (u32x2*)(XN + (size_t)m * DM) + lane;
#pragma unroll
            for (int r = 0; r < 4; ++r) { float sr = 0.f;
#pragma unroll
                for (int j = 0; j < 4; ++j) { const f32x4 y = v[r][j]; sr += sq4(y); u32x2 w; w.x = cvtpk(y[0], y[1]); w.y = cvtpk(y[2], y[3]); o8[256 * r + 64 * j] = w; }
                const float t = wave_sum(sr);
                if (lane == 0) ((float*)(ws + OFF_SSQ_X))[m + r] = t; }
        }
    }
    if (ws == nullptr) grid.sync();
    xcd_barrier(bar);
    { pg8::Gemm g{XN, WIN, M, N_IN, DM}; pg8::StaticOrder S; S.init(M, N_IN, G, (int)blockIdx.x);
      EpiProj E{ws};
      pg8::gemm_phase<EpiProj, pg8::StaticOrder, true, true>(lds, g, S, E); }
    xcd_barrier(bar);
    { int kq_ = 256; asm volatile("" : "+s"(kq_));
      pg8::Gemm g{CQKV, WUP, M, 768, kq_}; pg8::StaticOrder S; S.init(M, 768, G, (int)blockIdx.x);
      EpiUp E{ws, 0};
      pg8::gemm_phase<EpiUp, pg8::StaticOrder, true, true>(lds, g, S, E); }
    CONV_BY_IDLE((M / 256) * (768 / 256), 976 + 96 + 64, 976 + 96 + 64 + 512);
    __syncthreads();
    { int kk_ = 128; asm volatile("" : "+s"(kk_));
      pg8::Gemm g{CQKV + (size_t)M * 256, WUP + 768 * 256, M, 1024, kk_}; pg8::StaticOrder S; S.init(M, 1024, G, (int)blockIdx.x);
      EpiUp E{ws, 3};
      pg8::gemm_phase<EpiUp, pg8::StaticOrder, true, true>(lds, g, S, E); }
    xcd_barrier(bar);
    {
        int idx = att::attn_phase(lds, ws);
        constexpr int CB0 = 976 + 96 + 64 + 512, NCB = 2816 / NWAVES;
        LAS unsigned* qw = (LAS unsigned*)(lds + LDSCTL_OFF + 2048);
        while (idx < 1024 + NCB) {
            { const int one_ = CB0 + (idx - 1024) * NWAVES + wave; CONV_ITEMS(one_, one_ + 1, 0, 1); }
            if (tid == 0) *qw = atomicAdd((unsigned*)(ws + OFF_CTR), 1u);
            __syncthreads();
            idx = __builtin_amdgcn_readfirstlane((int)*qw);
            __syncthreads();
        }
    }
    xcd_barrier(bar);
    { pg8::Gemm g{OMIX, WO, M, DM, DM}; pg8::StaticOrder S; S.init(M, DM, G, (int)blockIdx.x);
      EpiWo E{x, out, ws};
      pg8::gemm_phase<EpiWo, pg8::StaticOrder, true, true>(lds, g, S, E); }
    xcd_barrier(bar);
    { pg8::Gemm g{H1B, WGU, M, N_GU, DM}; pg8::StaticOrder S; S.init(M, N_GU, G, (int)blockIdx.x);
      EpiGU E{ws};
      pg8::gemm_phase<EpiGU, pg8::StaticOrder, true, true>(lds, g, S, E); }
    CONV_BY_IDLE((M / 256) * (N_GU / 256), 976 + 96 + 64 + 512 + 2816, 976 + 96 + 64 + 512 + 2816 + 1408);
    xcd_barrier(bar);
    if (G == 256) {
        pg8::Gemm g{ACT, WD, M, DM, DFF}; pg8::StaticOrder S; S.init(M, DM, G, (int)blockIdx.x);
        EpiDownNorm E{out, norm_final, ws};
        pg8::gemm_phase<EpiDownNorm, pg8::StaticOrder, false, true>(lds, g, S, E);
    } else {
        { pg8::Gemm g{ACT, WD, M, DM, DFF}; pg8::StaticOrder S; S.init(M, DM, G, (int)blockIdx.x);
          EpiDown E{out, ws};
          pg8::gemm_phase<EpiDown, pg8::StaticOrder, true, true>(lds, g, S, E); }
        xcd_barrier(bar);
        const int gw = blockIdx.x * NWAVES + wave, NGW = G * NWAVES;
        for (int m = 2 * gw; m < M; m += 2 * NGW) {
            f32x4* xr = (f32x4*)(out + (size_t)m * DM) + lane; const f32x4* gr = (const f32x4*)norm_final + lane;
            f32x4 v[2][4]; float s0 = 0.f, s1 = 0.f;
#pragma unroll
            for (int j = 0; j < 4; ++j) { v[0][j] = xr[64 * j]; v[1][j] = xr[256 + 64 * j]; }
#pragma unroll
            for (int j = 0; j < 4; ++j) { s0 += sq4(v[0][j]); s1 += sq4(v[1][j]); }
            const float rs0 = 1.0f / __builtin_sqrtf(wave_sum(s0) * (1.f / DM) + EPS), rs1 = 1.0f / __builtin_sqrtf(wave_sum(s1) * (1.f / DM) + EPS);
#pragma unroll
            for (int j = 0; j < 4; ++j) { const f32x4 g = gr[64 * j]; xr[64 * j] = (v[0][j] * rs0) * g; xr[256 + 64 * j] = (v[1][j] * rs1) * g; }
        }
    }
}

extern "C" void kernel_launch(void* const* d_in, const int* in_sizes, int n_in, void* d_out, int out_size, void* d_ws, size_t ws_size, hipStream_t stream) {
    static int grid = 0;
    if (grid == 0) {
        if (n_in != 16 || out_size != M * DM || ws_size < WS_END) { fprintf(stderr, "kernel_launch: unexpected shapes (n_in %d out %d ws %zu)\n", n_in, out_size, ws_size); grid = -1; return; }
        int dev = 0, cus = 0, per_cu = 0;
        if (hipGetDevice(&dev) != hipSuccess || hipDeviceGetAttribute(&cus, hipDeviceAttributeMultiprocessorCount, dev) != hipSuccess) { grid = -1; return; }
        if (hipFuncSetAttribute((const void*)mk_fwd, hipFuncAttributeMaxDynamicSharedMemorySize, LDS_BYTES) != hipSuccess) { fprintf(stderr, "kernel_launch: hipFuncSetAttribute failed\n"); grid = -1; return; }
        if (hipOccupancyMaxActiveBlocksPerMultiprocessor(&per_cu, (const void*)mk_fwd, NWAVES * 64, LDS_BYTES) != hipSuccess || per_cu < 1) { fprintf(stderr, "kernel_launch: occupancy query gave %d\n", per_cu); per_cu = 1; }
        (void)hipGetLastError();
        grid = cus * per_cu;
    }
    if (grid < 0) return;
    (void)hipMemsetAsync((char*)d_ws + WS_CTL, 0, CTL_ZERO_BYTES, stream);
    Args a{};
    for (int i = 0; i < 16; ++i) a.in[i] = (const float*)d_in[i];
    a.out = (float*)d_out; a.ws = (unsigned char*)d_ws;
    void* args[] = {&a};
    hipError_t e = hipLaunchCooperativeKernel((const void*)mk_fwd, dim3(grid), dim3(NWAVES * 64), args, LDS_BYTES, stream);
    if (e != hipSuccess) fprintf(stderr, "cooperative launch failed: %s (grid %d)\n", hipGetErrorString(e), grid);
}
```

```cpp
#include <hip/hip_runtime.h>
#include <hip/hip_cooperative_groups.h>
#include <cstdio>
#include <cstdint>
namespace cg = cooperative_groups;

namespace pg8 {
#define PG8_LAS __attribute__((address_space(3)))
typedef unsigned short bf16_t;
typedef short bf16x8 __attribute__((ext_vector_type(8)));
typedef float f32x4 __attribute__((ext_vector_type(4)));
typedef unsigned u32x4 __attribute__((ext_vector_type(4)));
typedef unsigned u32x2 __attribute__((ext_vector_type(2)));
constexpr int BM = 256, BK = 64, HALF = 128, HTB = HALF * BK * 2, STAGE_BYTES = 8 * HTB, NXCD = 8, WGM = 8;

__host__ __device__ __forceinline__ int lds_byte(int r, int c) { const int st = (r >> 4) * 2 + (c >> 5), rr = r & 15, cc = c & 31, ob = rr * 64 + cc * 2; return st * 1024 + (ob ^ (((ob >> 9) & 1) << 5)); }
__host__ __device__ __forceinline__ void stage_rc(int b, int& R, int& C) { const int st = b / 1024, sb = b % 1024, swz = sb ^ (((sb >> 9) & 1) << 5); R = (st >> 1) * 16 + swz / 64; C = (st & 1) * 32 + (swz % 64) / 2; }
__host__ __device__ __forceinline__ int perm32(int rho) { const int n = rho >> 4, i = rho & 15; return 8 * (i >> 2) + 4 * n + (i & 3); }

struct Unit { int pm, pn; };
struct Gemm { const bf16_t* A; const bf16_t* Bt; int M, N, K; };

struct StaticOrder {
    int nM, nN, nwg, G, c;
    __host__ __device__ void init(int M, int N, int G_, int c_) { nM = M / BM; nN = N / BM; nwg = nM * nN; G = G_; c = c_; }
    __host__ __device__ bool next(int i, Unit& u) const {
        const long L = (long)i * G + c; if (L >= nwg) return false;
        int wgid = (int)L; { const int q = nwg / NXCD, r = nwg % NXCD, xcd = wgid % NXCD, off = wgid / NXCD; wgid = (xcd < r ? xcd * (q + 1) : r * (q + 1) + (xcd - r) * q) + off; }
        const int nig = WGM * nN, gid = wgid / nig, fm = gid * WGM, gsz = (nM - fm) < WGM ? (nM - fm) : WGM;
        u.pm = fm + ((wgid % nig) % gsz); u.pn = (wgid % nig) / gsz; return true;
    }
    __device__ __forceinline__ void a_ready(const Unit&) const {}
    __device__ __forceinline__ void done(const Unit&) const {}
};

typedef float f32x2_t __attribute__((ext_vector_type(2))); typedef __bf16 bf16x2_t __attribute__((ext_vector_type(2)));
__device__ __forceinline__ unsigned cvtpk(float lo, float hi) { f32x2_t v = {lo, hi}; bf16x2_t b = __builtin_convertvector(v, bf16x2_t); return __builtin_bit_cast(unsigned, b); }
__device__ __forceinline__ void store8(bf16_t* p, f32x4 v0, f32x4 v1) { u32x4 w; w.x = cvtpk(v0[0], v0[1]); w.y = cvtpk(v0[2], v0[3]); w.z = cvtpk(v1[0], v1[1]); w.w = cvtpk(v1[2], v1[3]); *(u32x4*)p = w; }
__device__ __forceinline__ void store4(bf16_t* p, f32x4 v0) { u32x2 w; w.x = cvtpk(v0[0], v0[1]); w.y = cvtpk(v0[2], v0[3]); *(u32x2*)p = w; }
__device__ __forceinline__ const char* uptr(const char* p) { const unsigned long long v = (unsigned long long)p; const unsigned lo = __builtin_amdgcn_readfirstlane((unsigned)v), hi = __builtin_amdgcn_readfirstlane((unsigned)(v >> 32)); return (const char*)(((unsigned long long)hi << 32) | lo); }

template <class Epi, class Sched, bool ALIGN_EPI = false, bool SP2 = false>
__device__ __forceinline__ void gemm_phase(PG8_LAS unsigned char* lds, const Gemm g, const Sched& S, const Epi& E) {
    const int tid = threadIdx.x, wid = __builtin_amdgcn_readfirstlane(tid >> 6), lane = tid & 63, wr = wid >> 2, wc = wid & 3, fr = lane & 15, fq = lane >> 4;
    const int K = g.K, nt = K / BK;
    unsigned voffA[2], voffB[2];
#pragma unroll
    for (int i = 0; i < 2; ++i) { int R, C; stage_rc(tid * 16 + i * 8192, R, C); const int Rb = Epi::PERM ? ((R & ~31) + perm32(R & 31)) : R;
        voffA[i] = (unsigned)(R * K + C) * 2u; voffB[i] = (unsigned)(Rb * K + C) * 2u; }
    const size_t kstep = (size_t)(BK * 2);
    const size_t hstep = (size_t)HALF * K * 2;
    const size_t tstep = 2 * hstep;
    const unsigned ldsw = (unsigned)wid * 1024u;
    const int aoff = lds_byte(wr * 64 + fr, fq * 8), boff = lds_byte(wc * 32 + fr, fq * 8);
#define PG8_SA(b, h) (((b) * 2 + (h)) * HTB)
#define PG8_SB(b, h) ((4 + (b) * 2 + (h)) * HTB)
#define PG8_STAGE(bufoff, gbase, voff) do { _Pragma("unroll") for (int _i = 0; _i < 2; ++_i) \
        __builtin_amdgcn_global_load_lds((const unsigned*)((const char*)(gbase) + (voff)[_i]), (PG8_LAS unsigned*)(lds + (bufoff) + ldsw + _i * 8192), 16, 0, 0); } while (0)
#define PG8_LDA(dst, b, h) do { _Pragma("unroll") for (int m = 0; m < 4; ++m) _Pragma("unroll") for (int k = 0; k < 2; ++k) dst[m][k] = *(const PG8_LAS bf16x8*)(lds + PG8_SA(b, h) + aoff + m * 2048 + k * 1024); } while (0)
#define PG8_LDB(dst, b, h) do { _Pragma("unroll") for (int n = 0; n < 2; ++n) _Pragma("unroll") for (int k = 0; k < 2; ++k) dst[n][k] = *(const PG8_LAS bf16x8*)(lds + PG8_SB(b, h) + boff + n * 2048 + k * 1024); } while (0)
#define PG8_MMA(ai, bj, At, Bt) do { __builtin_amdgcn_s_setprio(1); _Pragma("unroll") for (int m = 0; m < 4; ++m) _Pragma("unroll") for (int n = 0; n < 2; ++n) _Pragma("unroll") for (int k = 0; k < 2; ++k) \
        acc[ai][bj][m][n] = __builtin_amdgcn_mfma_f32_16x16x32_bf16(Bt[n][k], At[m][k], acc[ai][bj][m][n], 0, 0, 0); __builtin_amdgcn_s_setprio(0); } while (0)
#define PG8_WAIT_V(n) asm volatile("s_waitcnt vmcnt(" #n ")" ::: "memory")
#define PG8_WAIT_L(n) asm volatile("s_waitcnt lgkmcnt(" #n ")" ::: "memory")
#define PG8_BAR __builtin_amdgcn_s_barrier()
#define PG8_SCHED __builtin_amdgcn_sched_barrier(0)
    Unit cur, nxt; int ui = 0;
    if (!S.next(0, cur)) return;
    f32x4 acc[2][2][4][2];
#pragma unroll
    for (int a = 0; a < 2; ++a)
#pragma unroll
        for (int b = 0; b < 2; ++b)
#pragma unroll
            for (int m = 0; m < 4; ++m)
#pragma unroll
                for (int n = 0; n < 2; ++n) acc[a][b][m][n] = (f32x4){0.f, 0.f, 0.f, 0.f};
    bf16x8 At[4][2], B0[2][2], B1[2][2];
    const char* cA = uptr((const char*)g.A + (size_t)cur.pm * tstep); const char* cB = uptr((const char*)g.Bt + (size_t)cur.pn * tstep);
    S.a_ready(cur);
    if constexpr (SP2) {
        PG8_STAGE(PG8_SB(0, 0), cB, voffB); PG8_STAGE(PG8_SB(0, 1), cB + hstep, voffB); PG8_STAGE(PG8_SA(0, 0), cA, voffA); PG8_STAGE(PG8_SA(0, 1), cA + hstep, voffA);
        if (wr == 1) PG8_BAR;
        PG8_WAIT_V(2); PG8_BAR;
        PG8_STAGE(PG8_SB(1, 0), cB + kstep, voffB); PG8_STAGE(PG8_SA(1, 0), cA + kstep, voffA); PG8_STAGE(PG8_SB(1, 1), cB + hstep + kstep, voffB);
        PG8_WAIT_V(6); PG8_BAR;
    } else {
        PG8_STAGE(PG8_SB(0, 0), cB, voffB); PG8_STAGE(PG8_SA(0, 0), cA, voffA); PG8_STAGE(PG8_SB(0, 1), cB + hstep, voffB); PG8_STAGE(PG8_SA(0, 1), cA + hstep, voffA);
        if (wr == 1) PG8_BAR;
        PG8_WAIT_V(4); PG8_BAR;
        PG8_STAGE(PG8_SB(1, 0), cB + kstep, voffB); PG8_STAGE(PG8_SA(1, 0), cA + kstep, voffA); PG8_STAGE(PG8_SB(1, 1), cB + hstep + kstep, voffB);
        PG8_WAIT_V(6); PG8_BAR;
    }
    for (;;) {
        const bool has_next = S.next(ui + 1, nxt);
        const char* nA = uptr(has_next ? (const char*)g.A + (size_t)nxt.pm * tstep : cA); const char* nB = uptr(has_next ? (const char*)g.Bt + (size_t)nxt.pn * tstep : cB);
#pragma unroll 1
        for (int t = 0; t < nt; t += 2) {
            const bool last = (t == nt - 2);
            if constexpr (Epi::MID) { if (t == (nt >> 1)) E.mid(acc, cur, wr, wc, fr, fq); }
            const char* a1 = cA + (size_t)(t + 1) * kstep;
            const char* a2 = last ? nA : cA + (size_t)(t + 2) * kstep; const char* b2 = last ? nB : cB + (size_t)(t + 2) * kstep;
            const char* a3 = a2 + kstep; const char* b3 = b2 + kstep;
            if (last && has_next) S.a_ready(nxt);
            if constexpr (SP2) {
            PG8_LDB(B0, 0, 0); PG8_LDB(B1, 0, 1); PG8_SCHED; PG8_LDA(At, 0, 0); PG8_STAGE(PG8_SA(1, 1), a1 + hstep, voffA);
            PG8_WAIT_V(8); PG8_WAIT_L(0); PG8_BAR; PG8_MMA(0, 0, At, B0); PG8_MMA(0, 1, At, B1); PG8_BAR; PG8_SCHED;
            PG8_LDA(At, 0, 1); PG8_STAGE(PG8_SB(0, 0), b2, voffB); PG8_STAGE(PG8_SB(0, 1), b2 + hstep, voffB); PG8_STAGE(PG8_SA(0, 0), a2, voffA);
            PG8_WAIT_V(8); PG8_WAIT_L(0); PG8_BAR; PG8_MMA(1, 0, At, B0); PG8_MMA(1, 1, At, B1); PG8_BAR; PG8_SCHED;
            PG8_LDB(B0, 1, 0); PG8_LDB(B1, 1, 1); PG8_SCHED; PG8_LDA(At, 1, 0); PG8_STAGE(PG8_SA(0, 1), a2 + hstep, voffA);
            PG8_WAIT_V(8); PG8_WAIT_L(0); PG8_BAR; PG8_MMA(0, 0, At, B0); PG8_MMA(0, 1, At, B1); PG8_BAR; PG8_SCHED;
            PG8_LDA(At, 1, 1); PG8_STAGE(PG8_SB(1, 0), b3, voffB); PG8_STAGE(PG8_SB(1, 1), b3 + hstep, voffB); PG8_STAGE(PG8_SA(1, 0), a3, voffA);
            PG8_WAIT_V(8); PG8_WAIT_L(0); PG8_BAR; PG8_MMA(1, 0, At, B0); PG8_MMA(1, 1, At, B1); PG8_BAR; PG8_SCHED;
            } else {
            PG8_LDB(B0, 0, 0); PG8_SCHED; PG8_LDA(At, 0, 0); PG8_STAGE(PG8_SA(1, 1), a1 + hstep, voffA);
            PG8_WAIT_L(8); PG8_BAR; PG8_WAIT_L(0); PG8_MMA(0, 0, At, B0); PG8_BAR; PG8_SCHED;
            PG8_LDB(B1, 0, 1); PG8_STAGE(PG8_SB(0, 0), b2, voffB);
            PG8_BAR; PG8_WAIT_L(0); PG8_MMA(0, 1, At, B1); PG8_BAR;
            PG8_LDA(At, 0, 1); PG8_STAGE(PG8_SA(0, 0), a2, voffA);
            PG8_BAR; PG8_WAIT_L(0); PG8_MMA(1, 0, At, B0); PG8_BAR; PG8_SCHED;
            PG8_STAGE(PG8_SB(0, 1), b2 + hstep, voffB);
            PG8_WAIT_V(6); PG8_BAR; PG8_MMA(1, 1, At, B1); PG8_BAR;
            PG8_LDB(B0, 1, 0); PG8_SCHED; PG8_LDA(At, 1, 0); PG8_STAGE(PG8_SA(0, 1), a2 + hstep, voffA);
            PG8_WAIT_L(8); PG8_BAR; PG8_WAIT_L(0); PG8_MMA(0, 0, At, B0); PG8_BAR; PG8_SCHED;
            PG8_LDB(B1, 1, 1); PG8_STAGE(PG8_SB(1, 0), b3, voffB);
            PG8_BAR; PG8_WAIT_L(0); PG8_MMA(0, 1, At, B1); PG8_BAR;
            PG8_LDA(At, 1, 1); PG8_STAGE(PG8_SA(1, 0), a3, voffA);
            PG8_BAR; PG8_WAIT_L(0); PG8_MMA(1, 0, At, B0); PG8_BAR; PG8_SCHED;
            PG8_STAGE(PG8_SB(1, 1), b3 + hstep, voffB);
            PG8_WAIT_V(6); PG8_BAR; PG8_MMA(1, 1, At, B1); PG8_BAR;
            }
        }
        if constexpr (ALIGN_EPI) { if (wr == 0) PG8_BAR; }
        if constexpr (!Epi::AFTER_DRAIN) { E(acc, cur, wr, wc, fr, fq); S.done(cur); }
        if (!has_next) break;
#pragma unroll
        for (int a = 0; a < 2; ++a)
#pragma unroll
            for (int b = 0; b < 2; ++b)
#pragma unroll
                for (int m = 0; m < 4; ++m)
#pragma unroll
                    for (int n = 0; n < 2; ++n) acc[a][b][m][n] = (f32x4){0.f, 0.f, 0.f, 0.f};
        cur = nxt; cA = nA; cB = nB; ++ui;
        if constexpr (ALIGN_EPI) { if (wr == 1) PG8_BAR; }
    }
    PG8_WAIT_V(0);
    if constexpr (!ALIGN_EPI) { if (wr == 0) PG8_BAR; }
    PG8_BAR;
    if constexpr (Epi::AFTER_DRAIN) { E.fused(acc, cur, wr, wc, fr, fq, lds, wid, lane); S.done(cur); }
#undef PG8_SA
#undef PG8_SB
#undef PG8_STAGE
#undef PG8_LDA
#undef PG8_LDB
#undef PG8_MMA
#undef PG8_WAIT_V
#undef PG8_WAIT_L
#undef PG8_BAR
#undef PG8_SCHED
}
}

constexpr int BATCH = 2, SEQ = 8192, M = BATCH * SEQ, DM = 1024, DFF = 2816;
constexpr int N_IN = 2048, N_UP = 1792, K_UP = 384, N_GU = 2 * DFF;
constexpr float EPS = 1e-6f;
constexpr float C2Q = 0.1472444460259031f;
constexpr float C2S = 0.18033688011112042f;

constexpr size_t MiB = 1u << 20;
constexpr size_t WS_CTL = 0, CTL_ZERO_BYTES = 544 * 1024;
constexpr size_t OFF_SSQ_CQ = 0, OFF_SSQ_CKV = 65536, OFF_SSQ_MLA = 131072, OFF_SSQ_SB = 196608, OFF_SSQ_H1 = 262144, OFF_SSQ_H2 = 327680, OFF_CTR = 393216, OFF_CNT = 409600, OFF_SSQ_X = 458752, OFF_BAR = 524288;
constexpr size_t WS_WIN = 2 * MiB;
constexpr size_t WS_WUP = 6 * MiB;
constexpr size_t WS_WO = 8 * MiB;
constexpr size_t WS_WGU = 10 * MiB;
constexpr size_t WS_WD = 22 * MiB;
constexpr size_t WS_CS = 28 * MiB;
constexpr size_t WS_XN = 32 * MiB;
constexpr size_t WS_CQKV = 64 * MiB;
constexpr size_t WS_KR = 76 * MiB;
constexpr size_t WS_QSB = 80 * MiB, WS_KSB = 96 * MiB, WS_VSB = 112 * MiB;
constexpr size_t WS_QMLA = 128 * MiB;
constexpr size_t WS_KVMLA = 152 * MiB;
constexpr size_t WS_OMIX = 184 * MiB;
constexpr size_t WS_ACT = 64 * MiB;
constexpr size_t WS_H1B = 216 * MiB;
constexpr size_t WS_END = 248 * MiB;
static_assert(WS_ACT + (size_t)M * DFF * 2 <= WS_KVMLA + 32 * MiB && WS_ACT + (size_t)M * DFF * 2 <= WS_OMIX, "ACT overlay");
#define WSP(T, off) ((T*)(ws + (off)))

using pg8::bf16_t; using pg8::bf16x8; using pg8::f32x4; using pg8::u32x4; using pg8::u32x2; using pg8::Unit; using pg8::cvtpk; using pg8::store8; using pg8::store4;
#define LAS __attribute__((address_space(3)))

__device__ __forceinline__ float rsq(float x) { return __builtin_amdgcn_rsqf(x); }

__device__ __forceinline__ f32x4 rope4(f32x4 v, const float2* cs4, float sg) {
    f32x4 r;
#pragma unroll
    for (int e = 0; e < 4; ++e) { const float oth = __shfl_xor(v[e], 32); const float2 c = cs4[e]; r[e] = v[e] * c.x + sg * (oth * c.y); }
    return r;
}
__device__ __forceinline__ f32x4 ld4bf(const bf16_t* p) { const u32x2 w = *(const u32x2*)p; return (f32x4){__uint_as_float(w.x << 16), __uint_as_float(w.x & 0xffff0000u), __uint_as_float(w.y << 16), __uint_as_float(w.y & 0xffff0000u)}; }
__device__ __forceinline__ float sq4(f32x4 v) { return (v[0] * v[0] + v[1] * v[1]) + (v[2] * v[2] + v[3] * v[3]); }
#define EPI_LANE() int fr = fr_in, fq = fq_in; asm volatile("" : "+v"(fr), "+v"(fq))

struct EpiProj {
    static constexpr bool PERM = true, AFTER_DRAIN = false, MID = false;
    unsigned char* ws;
    __device__ __forceinline__ void operator()(const f32x4 (&acc)[2][2][4][2], const Unit& u, int wr, int wc, int fr_in, int fq_in) const {
        EPI_LANE();
        const int pn = u.pn, row0 = u.pm * 256 + wr * 64 + fr;
#define RSX(ai, m) rsq(WSP(const float, OFF_SSQ_X)[(unsigned)(row0 + (ai) * 128 + (m) * 16)] * (1.f / DM) + EPS)
        if (pn >= 2) {
            const int t = (pn - 2) >> 1; bf16_t* base = WSP(bf16_t, WS_QSB) + (size_t)t * ((WS_KSB - WS_QSB) / 2); const float sc = (t == 0) ? C2S : 1.f;
            const int col0 = ((pn - 2) & 1) * 256 + wc * 32 + 8 * fq;
#pragma unroll
            for (int ai = 0; ai < 2; ++ai)
#pragma unroll
                for (int m = 0; m < 4; ++m) { bf16_t* rowp = base + (unsigned)((row0 + ai * 128 + m * 16) * 512 + col0); const float sr = sc * RSX(ai, m);
#pragma unroll
                    for (int bj = 0; bj < 2; ++bj) store8(rowp + bj * 128, acc[ai][bj][m][0] * sr, acc[ai][bj][m][1] * sr);
                    asm volatile("" ::: "memory"); }
        } else if (pn == 0) {
            const int col0 = wc * 32 + 8 * fq;
#pragma unroll
            for (int ai = 0; ai < 2; ++ai)
#pragma unroll
                for (int m = 0; m < 4; ++m) { const int row = row0 + ai * 128 + m * 16; bf16_t* rowp = WSP(bf16_t, WS_CQKV) + (unsigned)(row * 256 + col0); float ss = 0.f; const float sr = RSX(ai, m);
#pragma unroll
                    for (int bj = 0; bj < 2; ++bj) { const f32x4 v0 = acc[ai][bj][m][0] * sr, v1 = acc[ai][bj][m][1] * sr; ss += sq4(v0) + sq4(v1); store8(rowp + bj * 128, v0, v1); }
                    ss += __shfl_xor(ss, 16); ss += __shfl_xor(ss, 32);
                    if (fq == 0) atomicAdd(WSP(float, OFF_SSQ_CQ) + (unsigned)row, ss); }
        } else {
            const int col0 = wc * 32 + 8 * fq; const float sg = (fq < 2) ? -1.f : 1.f;
#pragma unroll
            for (int ai = 0; ai < 2; ++ai)
#pragma unroll
                for (int m = 0; m < 4; ++m) { const int row = row0 + ai * 128 + m * 16;
                    const float sr = RSX(ai, m);
                    const f32x4 c0 = acc[ai][0][m][0] * sr, c1 = acc[ai][0][m][1] * sr;
                    float ss = sq4(c0) + sq4(c1);
                    store8(WSP(bf16_t, WS_CQKV) + (unsigned)(M * 256 + row * 128 + col0), c0, c1);
                    ss += __shfl_xor(ss, 16); ss += __shfl_xor(ss, 32);
                    if (fq == 0) atomicAdd(WSP(float, OFF_SSQ_CKV) + (unsigned)row, ss);
                    if (wc == 0) { const float2* cs = WSP(const float2, WS_CS) + (unsigned)(row * 16 + 8 * (fq & 1));
                        const f32x4 v0 = rope4(acc[ai][1][m][0] * sr, cs, sg), v1 = rope4(acc[ai][1][m][1] * sr, cs + 4, sg); store8(WSP(bf16_t, WS_KR) + (unsigned)(row * 32 + 8 * fq), v0, v1); }
                    asm volatile("" ::: "memory"); }
        }
    }
};

struct EpiUp {
    static constexpr bool PERM = true, AFTER_DRAIN = false, MID = false;
    unsigned char* ws; int pn_off;
    __device__ __forceinline__ void operator()(const f32x4 (&acc)[2][2][4][2], const Unit& u, int wr, int wc, int fr_in, int fq_in) const {
        EPI_LANE();
        const int pn = u.pn + pn_off, row0 = u.pm * 256 + wr * 64 + fr;
        if (pn < 3) {
            const float sg = (fq < 2) ? -1.f : 1.f;
#pragma unroll
            for (int ai = 0; ai < 2; ++ai)
#pragma unroll
                for (int m = 0; m < 4; ++m) { const int row = row0 + ai * 128 + m * 16; const float rs = rsq(WSP(const float, OFF_SSQ_CQ)[(unsigned)row] * (1.f / 256.f) + EPS);
#pragma unroll
                    for (int bj = 0; bj < 2; ++bj) { const int G = 8 * pn + 4 * bj + wc; f32x4 v0 = acc[ai][bj][m][0] * rs, v1 = acc[ai][bj][m][1] * rs;
                        if ((G % 3) == 2) { const float2* cs = WSP(const float2, WS_CS) + (unsigned)(row * 16 + 8 * (fq & 1)); v0 = rope4(v0, cs, sg); v1 = rope4(v1, cs + 4, sg); }
                        store8(WSP(bf16_t, WS_QMLA) + (unsigned)(row * 768 + 32 * G + 8 * fq), v0 * C2Q, v1 * C2Q);
                        asm volatile("" ::: "memory"); } }
        } else {
            const int col0 = (pn - 3) * 256 + wc * 32 + 8 * fq;
#pragma unroll
            for (int ai = 0; ai < 2; ++ai)
#pragma unroll
                for (int m = 0; m < 4; ++m) { const int row = row0 + ai * 128 + m * 16; const float rs = rsq(WSP(const float, OFF_SSQ_CKV)[(unsigned)row] * (1.f / 128.f) + EPS);
#pragma unroll
                    for (int bj = 0; bj < 2; ++bj) store8(WSP(bf16_t, WS_KVMLA) + (unsigned)(row * 1024 + col0 + bj * 128), acc[ai][bj][m][0] * rs, acc[ai][bj][m][1] * rs);
                    asm volatile("" ::: "memory"); }
        }
    }
};

struct EpiWo {
    static constexpr bool PERM = false, AFTER_DRAIN = false, MID = true;
    const float* x; float* h1; unsigned char* ws;
    __device__ __forceinline__ void mid(f32x4 (&acc)[2][2][4][2], const Unit& u, int wr, int wc, int fr_in, int fq_in) const {
        EPI_LANE();
        const int row0 = u.pm * 256 + wr * 64 + fr;
#pragma unroll
        for (int ai = 0; ai < 2; ++ai)
#pragma unroll
            for (int m = 0; m < 4; ++m) { const int row = row0 + ai * 128 + m * 16;
                const float a = WSP(const float, OFF_SSQ_MLA)[(unsigned)row] * (1.f / 512.f) + EPS, b = WSP(const float, OFF_SSQ_SB)[(unsigned)row] * (1.f / 512.f) + EPS; const float ratio = __builtin_sqrtf(b) * rsq(a);
#pragma unroll
                for (int bj = 0; bj < 2; ++bj)
#pragma unroll
                    for (int n = 0; n < 2; ++n) acc[ai][bj][m][n] *= ratio;
                asm volatile("" ::: "memory"); }
    }
    __device__ __forceinline__ void operator()(const f32x4 (&acc)[2][2][4][2], const Unit& u, int wr, int wc, int fr_in, int fq_in) const {
        EPI_LANE();
        const int row0 = u.pm * 256 + wr * 64 + fr, col0 = u.pn * 256 + wc * 32 + 4 * fq;
#pragma unroll
        for (int ai = 0; ai < 2; ++ai)
#pragma unroll
            for (int m = 0; m < 4; ++m) { const int row = row0 + ai * 128 + m * 16; const float rs = rsq(WSP(const float, OFF_SSQ_SB)[(unsigned)row] * (1.f / 512.f) + EPS); float ss = 0.f; const unsigned off = (unsigned)(row * DM + col0);
#pragma unroll
                for (int bj = 0; bj < 2; ++bj)
#pragma unroll
                    for (int n = 0; n < 2; ++n) { const unsigned o = off + bj * 128 + n * 16; const f32x4 h = ld4bf(WSP(const bf16_t, WS_XN) + o) + acc[ai][bj][m][n] * rs; ss += sq4(h);
                        store4(WSP(bf16_t, WS_H1B) + o, h); }
                ss += __shfl_xor(ss, 16); ss += __shfl_xor(ss, 32);
                if (fq == 0) atomicAdd(WSP(float, OFF_SSQ_H1) + (unsigned)row, ss);
                asm volatile("" ::: "memory"); }
    }
};

struct EpiGU {
    static constexpr bool PERM = true, AFTER_DRAIN = false, MID = false;
    unsigned char* ws;
    __device__ __forceinline__ void operator()(const f32x4 (&acc)[2][2][4][2], const Unit& u, int wr, int wc, int fr_in, int fq_in) const {
        EPI_LANE();
        const int row0 = u.pm * 256 + wr * 64 + fr, col0 = u.pn * 128 + wc * 16 + 4 * fq;
#pragma unroll
        for (int ai = 0; ai < 2; ++ai)
#pragma unroll
            for (int m = 0; m < 4; ++m) { const int row = row0 + ai * 128 + m * 16; const float rs = rsq(WSP(const float, OFF_SSQ_H1)[(unsigned)row] * (1.f / 1024.f) + EPS);
#pragma unroll
                for (int bj = 0; bj < 2; ++bj) { const f32x4 g = acc[ai][bj][m][0] * rs, up = acc[ai][bj][m][1] * rs; f32x4 a;
#pragma unroll
                    for (int e = 0; e < 4; ++e) a[e] = g[e] * __builtin_amdgcn_rcpf(1.f + __builtin_amdgcn_exp2f(-1.4426950408889634f * g[e])) * up[e];
                    store4(WSP(bf16_t, WS_ACT) + (unsigned)(row * DFF + col0 + bj * 64), a); } }
    }
};

struct EpiDown {
    static constexpr bool PERM = false, AFTER_DRAIN = false, MID = false;
    float* h; unsigned char* ws;
    __device__ __forceinline__ void operator()(const f32x4 (&acc)[2][2][4][2], const Unit& u, int wr, int wc, int fr_in, int fq_in) const {
        EPI_LANE();
        const int row0 = u.pm * 256 + wr * 64 + fr, col0 = u.pn * 256 + wc * 32 + 4 * fq;
#pragma unroll
        for (int ai = 0; ai < 2; ++ai)
#pragma unroll
            for (int m = 0; m < 4; ++m) { const unsigned off = (unsigned)((row0 + ai * 128 + m * 16) * DM + col0);
#pragma unroll
                for (int bj = 0; bj < 2; ++bj)
#pragma unroll
                    for (int n = 0; n < 2; ++n) { const unsigned o = off + bj * 128 + n * 16; *(f32x4*)(h + o) = ld4bf(WSP(const bf16_t, WS_H1B) + o) + acc[ai][bj][m][n]; }
                asm volatile("" ::: "memory"); }
    }
};

struct EpiDownNorm {
    static constexpr bool PERM = false, AFTER_DRAIN = true, MID = false;
    float* h; const float* gfin; unsigned char* ws;
    __device__ __forceinline__ void fused(f32x4 (&acc)[2][2][4][2], const Unit& u, int wr, int wc, int fr_in, int fq_in, PG8_LAS unsigned char* lds, int wid, int lane) const {
        EPI_LANE();
        const int row0 = u.pm * 256 + wr * 64 + fr, col0 = u.pn * 256 + wc * 32 + 4 * fq;
        float* ssq = WSP(float, OFF_SSQ_H2);
#pragma unroll
        for (int ai = 0; ai < 2; ++ai)
#pragma unroll
            for (int m = 0; m < 4; ++m) { const int row = row0 + ai * 128 + m * 16; const unsigned off = (unsigned)(row * DM + col0); float ss = 0.f;
#pragma unroll
                for (int bj = 0; bj < 2; ++bj)
#pragma unroll
                    for (int n = 0; n < 2; ++n) { const unsigned o = off + bj * 128 + n * 16; acc[ai][bj][m][n] += ld4bf(WSP(const bf16_t, WS_H1B) + o); ss += sq4(acc[ai][bj][m][n]); }
                ss += __shfl_xor(ss, 16); ss += __shfl_xor(ss, 32);
                if (fq == 0) atomicAdd(ssq + (unsigned)row, ss);
                asm volatile("" ::: "memory"); }
        asm volatile("s_waitcnt vmcnt(0)" ::: "memory");
        __syncthreads();
        unsigned* cnt = WSP(unsigned, OFF_CNT) + 64 * u.pm;
        if (threadIdx.x == 0) {
            __hip_atomic_fetch_add(cnt, 1u, __ATOMIC_RELAXED, __HIP_MEMORY_SCOPE_AGENT);
            unsigned sp = 0;
            while (__hip_atomic_load(cnt, __ATOMIC_RELAXED, __HIP_MEMORY_SCOPE_AGENT) < 4u) { __builtin_amdgcn_s_sleep(2); if (++sp > (1u << 22)) break; }
            __builtin_amdgcn_fence(__ATOMIC_ACQUIRE, "agent");
        }
        __syncthreads();
#pragma unroll
        for (int ai = 0; ai < 2; ++ai)
#pragma unroll
            for (int m = 0; m < 4; ++m) { const int row = row0 + ai * 128 + m * 16; const unsigned off = (unsigned)(row * DM + col0);
                const float tot = __hip_atomic_load(ssq + (unsigned)row, __ATOMIC_RELAXED, __HIP_MEMORY_SCOPE_AGENT); const float rs = 1.0f / __builtin_sqrtf(tot * (1.f / DM) + EPS);
#pragma unroll
                for (int bj = 0; bj < 2; ++bj)
#pragma unroll
                    for (int n = 0; n < 2; ++n) { const unsigned o = off + bj * 128 + n * 16; const f32x4 g4 = *(const f32x4*)(gfin + (col0 + bj * 128 + n * 16)); __builtin_nontemporal_store((acc[ai][bj][m][n] * rs) * g4, (f32x4*)(h + o)); }
                asm volatile("" ::: "memory"); }
    }
};

namespace att {
typedef LAS unsigned char lds_u8;
typedef float f32x16 __attribute__((ext_vector_type(16)));
typedef short s16x4 __attribute__((ext_vector_type(4)));
typedef short v4i16_t __attribute__((ext_vector_type(4)));
constexpr int KBUF = 12288, VBUF = 8192;
constexpr int KSLOTS = 4, VSLOTS = 4;
constexpr int L_K = 0, L_V = KSLOTS * KBUF, L_WSF = L_V + VSLOTS * VBUF, L_STG = L_WSF + 2048, L_FLAG = L_STG + 8 * 4096, L_UNIT = L_FLAG + 64, L_END = L_UNIT + 16;
static_assert(L_END <= 131072, "attention LDS map");
constexpr int ML_K = L_K, ML_V = L_V;
#define MFMA32(a, b, c) __builtin_amdgcn_mfma_f32_32x32x16_bf16((a), (b), (c), 0, 0, 0)
__device__ __forceinline__ s16x4 vtr(lds_u8* p) { return __builtin_bit_cast(s16x4, __builtin_amdgcn_ds_read_tr16_b64_v4i16((LAS v4i16_t*)p)); }
__device__ __forceinline__ bf16x8 pk8(const f32x16& p, int b) { u32x4 w; w.x = cvtpk(p[b], p[b + 1]); w.y = cvtpk(p[b + 2], p[b + 3]); w.z = cvtpk(p[b + 4], p[b + 5]); w.w = cvtpk(p[b + 6], p[b + 7]); return __builtin_bit_cast(bf16x8, w); }
__device__ __forceinline__ float ex2(float x) { return __builtin_amdgcn_exp2f(x); }
__device__ __forceinline__ float lg2(float x) { return __builtin_amdgcn_logf(x); }


template <int ND> __device__ __forceinline__ void qk_tile(f32x16& p0, f32x16& p1, lds_u8* kp, const bf16x8 (&qr)[ND]) {
#pragma unroll
    for (int d0 = 0; d0 < ND; ++d0) {
        const bf16x8 b0 = *(LAS bf16x8*)(kp + d0 * 2048), b1 = *(LAS bf16x8*)(kp + d0 * 2048 + 512);
        p0 = MFMA32(b0, qr[d0], p0); p1 = MFMA32(b1, qr[d0], p1); }
}
__device__ __forceinline__ void pv_tile(f32x16 (&o)[2], lds_u8* vp, const f32x16& p0, const f32x16& p1) {
    const bf16x8 pa0 = pk8(p0, 0), pa1 = pk8(p0, 8), pa2 = pk8(p1, 0), pa3 = pk8(p1, 8);
#pragma unroll
    for (int d0 = 0; d0 < 2; ++d0) {
        s16x4 lo[4], hh[4];
#pragma unroll
        for (int ks = 0; ks < 4; ++ks) { lo[ks] = vtr(vp + d0 * 4096 + ks * 1024); hh[ks] = vtr(vp + d0 * 4096 + ks * 1024 + 512); }
#define VF(k) (bf16x8){lo[k][0], lo[k][1], lo[k][2], lo[k][3], hh[k][0], hh[k][1], hh[k][2], hh[k][3]}
        o[d0] = MFMA32(pa0, VF(0), o[d0]); o[d0] = MFMA32(pa1, VF(1), o[d0]); o[d0] = MFMA32(pa2, VF(2), o[d0]); o[d0] = MFMA32(pa3, VF(3), o[d0]);
#undef VF
    }
}
__device__ __forceinline__ void pv_tile4(f32x16 (&o)[2], lds_u8* vp, bf16x8 pa0, bf16x8 pa1, bf16x8 pa2, bf16x8 pa3) {
#pragma unroll
    for (int d0 = 0; d0 < 2; ++d0) {
        s16x4 lo[4], hh[4];
#pragma unroll
        for (int ks = 0; ks < 4; ++ks) { lo[ks] = vtr(vp + d0 * 4096 + ks * 1024); hh[ks] = vtr(vp + d0 * 4096 + ks * 1024 + 512); }
#define VF(k) (bf16x8){lo[k][0], lo[k][1], lo[k][2], lo[k][3], hh[k][0], hh[k][1], hh[k][2], hh[k][3]}
        o[d0] = MFMA32(pa0, VF(0), o[d0]); o[d0] = MFMA32(pa1, VF(1), o[d0]); o[d0] = MFMA32(pa2, VF(2), o[d0]); o[d0] = MFMA32(pa3, VF(3), o[d0]);
#undef VF
    }
}
template <int ND> __device__ __forceinline__ void qk_tile_c(f32x16& p0, f32x16& p1, lds_u8* kp, const bf16x8 (&qr)[ND], const f32x16& cinit) {
#pragma unroll
    for (int d0 = 0; d0 < ND; ++d0) {
        const bf16x8 b0 = *(LAS bf16x8*)(kp + d0 * 2048), b1 = *(LAS bf16x8*)(kp + d0 * 2048 + 512);
        if (d0 == 0) { p0 = MFMA32(b0, qr[0], cinit); p1 = MFMA32(b1, qr[0], cinit); }
        else { p0 = MFMA32(b0, qr[d0], p0); p1 = MFMA32(b1, qr[d0], p1); }
    }
}
__device__ __forceinline__ float max3f(float a, float b, float c) { float r; asm("v_max3_f32 %0, %1, %2, %3" : "=v"(r) : "v"(a), "v"(b), "v"(c)); return r; }
__device__ __forceinline__ float rowmax32(const f32x16& p0, const f32x16& p1) {
    float a, b;
    asm volatile("s_nop 15\n\ts_nop 7\n\tv_max3_f32 %0, %2, %3, %4\n\tv_max3_f32 %1, %5, %6, %7" : "=&v"(a), "=&v"(b) : "v"(p0[0]), "v"(p0[1]), "v"(p1[0]), "v"(p0[2]), "v"(p0[3]), "v"(p1[1]));
    a = max3f(a, p1[2], p1[3]);
#pragma unroll
    for (int r = 4; r < 16; r += 4) { a = max3f(a, p0[r], p0[r + 1]); b = max3f(b, p0[r + 2], p0[r + 3]); a = max3f(a, p1[r], p1[r + 1]); b = max3f(b, p1[r + 2], p1[r + 3]); }
    return max3f(a, b, b);
}
__device__ __forceinline__ void pv_tile5(f32x16 (&o)[3], lds_u8* vp, bf16x8 pa0, bf16x8 pa1, bf16x8 pa2, bf16x8 pa3, bf16x8 ones) {
#pragma unroll
    for (int d0 = 0; d0 < 2; ++d0) {
        s16x4 lo[4], hh[4];
#pragma unroll
        for (int ks = 0; ks < 4; ++ks) { lo[ks] = vtr(vp + d0 * 4096 + ks * 1024); hh[ks] = vtr(vp + d0 * 4096 + ks * 1024 + 512); }
#define VF(k) (bf16x8){lo[k][0], lo[k][1], lo[k][2], lo[k][3], hh[k][0], hh[k][1], hh[k][2], hh[k][3]}
        o[d0] = MFMA32(pa0, VF(0), o[d0]); o[d0] = MFMA32(pa1, VF(1), o[d0]); o[d0] = MFMA32(pa2, VF(2), o[d0]); o[d0] = MFMA32(pa3, VF(3), o[d0]);
#undef VF
    }
    o[2] = MFMA32(pa0, ones, o[2]); o[2] = MFMA32(pa1, ones, o[2]); o[2] = MFMA32(pa2, ones, o[2]); o[2] = MFMA32(pa3, ones, o[2]);
}
template <int NO> __device__ __forceinline__ void store_o(lds_u8* lds, unsigned char* ws, const f32x16 (&o)[NO], const float (&rli)[16], size_t rowbase, int q0, int wid, int lane, int r32, int hi, int col0, int h, size_t ssq_off) {
    LAS bf16_t* stg = (LAS bf16_t*)(lds + L_STG) + wid * 2048;
#pragma unroll
    for (int r = 0; r < 16; ++r) { const int orow = (r & 3) + 8 * (r >> 2) + 4 * hi;
#pragma unroll
        for (int d0 = 0; d0 < 2; ++d0) stg[orow * 64 + d0 * 32 + r32] = (bf16_t)(cvtpk(o[d0][r] * rli[r], 0.f) & 0xffffu); }
    asm volatile("s_waitcnt lgkmcnt(0)" ::: "memory");
    bf16_t* Ow = WSP(bf16_t, WS_OMIX) + (rowbase + q0 + wid * 32) * 1024 + col0 + h * 64;
    float* ssq = (float*)(ws + ssq_off) + rowbase + q0 + wid * 32;
#pragma unroll
    for (int i = 0; i < 4; ++i) { const int row = i * 8 + (lane >> 3), ch = lane & 7; const u32x4 v = *(LAS u32x4*)(stg + row * 64 + ch * 8);
        float ss = 0.f;
#pragma unroll
        for (int e = 0; e < 4; ++e) { const float a = __uint_as_float(v[e] << 16), bb = __uint_as_float(v[e] & 0xffff0000u); ss += a * a + bb * bb; }
        ss += __shfl_xor(ss, 1); ss += __shfl_xor(ss, 2); ss += __shfl_xor(ss, 4);
        if (ch == 0) atomicAdd(ssq + row, ss);
        *(u32x4*)(Ow + (unsigned)(row * 1024 + ch * 8)) = v; }
}
__device__ __forceinline__ float max16(const f32x16& p) {
    float a = fmaxf(fmaxf(p[0], p[1]), fmaxf(p[2], p[3])), b = fmaxf(fmaxf(p[4], p[5]), fmaxf(p[6], p[7]));
    float c = fmaxf(fmaxf(p[8], p[9]), fmaxf(p[10], p[11])), d = fmaxf(fmaxf(p[12], p[13]), fmaxf(p[14], p[15]));
    return fmaxf(fmaxf(a, b), fmaxf(c, d));
}
__device__ __forceinline__ float sum16(const f32x16& p) {
    return (((p[0] + p[1]) + (p[2] + p[3])) + ((p[4] + p[5]) + (p[6] + p[7]))) + (((p[8] + p[9]) + (p[10] + p[11])) + ((p[12] + p[13]) + (p[14] + p[15])));
}

__device__ __forceinline__ void sb_half(f32x16& p, float& C, int hi, bool diag, int kvb, int qrel) {
    float R[16];
#pragma unroll
    for (int r = 0; r < 16; ++r) { const float e = ex2(__builtin_amdgcn_fmed3f(p[r], -126.f, 126.f)); const float rr = __builtin_amdgcn_rcpf(1.f + e); R[r] = rr; p[r] = e * rr; }
    if (diag) {
#pragma unroll
        for (int r = 0; r < 16; ++r) { const int kv = kvb + (r & 3) + 8 * (r >> 2); if (kv >= qrel) { R[r] = 1.f; p[r] = 0.f; } }
    }
    float G[4], Gp[4], E[4];
#pragma unroll
    for (int g = 0; g < 4; ++g) { G[g] = (R[4 * g] * R[4 * g + 1]) * (R[4 * g + 2] * R[4 * g + 3]); Gp[g] = __shfl_xor(G[g], 32); }
    float acc = C;
#pragma unroll
    for (int g = 3; g >= 0; --g) { E[g] = acc * (hi == 0 ? Gp[g] : 1.f); acc *= G[g] * Gp[g]; }
    C = acc;
#pragma unroll
    for (int g = 0; g < 4; ++g) {
        float s = E[g];
#pragma unroll
        for (int i = 3; i >= 0; --i) { const int r = 4 * g + i; p[r] *= s; s *= R[r]; }
    }
}
__device__ __forceinline__ void sb_transform(f32x16& p0, f32x16& p1, float& c, int hi, bool diag, int kvb, int qrel) {
    sb_half(p1, c, hi, diag, kvb + 32, qrel);
    __builtin_amdgcn_sched_barrier(0);
    sb_half(p0, c, hi, diag, kvb, qrel);
}


__device__ __forceinline__ void glds16(const void* gsrc, unsigned lds_dst) { unsigned keep;
    asm volatile("s_mov_b32 %0, m0\n\ts_mov_b32 m0, %2\n\ts_nop 0\n\tglobal_load_lds_dwordx4 %1, off\n\ts_mov_b32 m0, %0" : "=&s"(keep) : "v"(gsrc), "s"(lds_dst) : "memory"); }
__device__ __forceinline__ void mla_unit(lds_u8* lds, unsigned char* ws, int b, int h, int qb) {
    const int tid = threadIdx.x, lane = tid & 63, r32 = lane & 31, hi = lane >> 5; const int wid = __builtin_amdgcn_readfirstlane(tid >> 6);
    const size_t rowbase = (size_t)b * SEQ; const int q0 = qb * 256;
    const bf16_t* Qb = WSP(const bf16_t, WS_QMLA) + (rowbase + q0) * 768 + h * 96;
    const char* Kb = (const char*)(WSP(const bf16_t, WS_KVMLA) + rowbase * 1024 + h * 128);
    const char* Vb = Kb + 128;
    const char* KRb = (const char*)(WSP(const bf16_t, WS_KR) + rowbase * 32);
    const unsigned koff = (unsigned)(lane * 1024 + wid * 8) * 2u, kroff = (unsigned)(lane * 32 + (wid & 3) * 8) * 2u,
                   voff = (unsigned)((16 * (wid & 3) + (lane >> 2)) * 1024 + (wid >> 2) * 32 + (lane & 3) * 8) * 2u;
#define DMA16(src, dst) glds16((src), (unsigned)__builtin_amdgcn_readfirstlane((int)(unsigned)(uintptr_t)(dst)))
#define DMA_K(t, slot) do { DMA16(Kb + (koff + (unsigned)(t) * (64u * 2048u)), lds + L_K + (slot) * KBUF + wid * 1024); \
        if (wid < 4) DMA16(KRb + (kroff + (unsigned)(t) * (64u * 64u)), lds + L_K + (slot) * KBUF + (8 + wid) * 1024); } while (0)
#define DMA_V(t, slot) DMA16(Vb + (voff + (unsigned)(t) * (64u * 2048u)), lds + L_V + (slot) * VBUF + wid * 1024)
#define WAIT_SYNC() do { asm volatile("s_waitcnt vmcnt(0)" ::: "memory"); __syncthreads(); } while (0)
#define WAIT_SYNC_AHEAD() do { if (wid < 4) asm volatile("s_waitcnt vmcnt(3)" ::: "memory"); else asm volatile("s_waitcnt vmcnt(2)" ::: "memory"); __syncthreads(); } while (0)
    const int NT = 4 * (qb + 1);
    const int Tw = min(NT, NT - 3 + (wid >> 1));
    DMA_K(0, 0); DMA_K(1, 1); DMA_V(0, 0);
    bf16x8 qr[6];
#pragma unroll
    for (int d0 = 0; d0 < 6; ++d0) qr[d0] = *(const bf16x8*)(Qb + (unsigned)((wid * 32 + r32) * 768 + d0 * 16 + hi * 8));
    WAIT_SYNC();
    lds_u8* kp0 = lds + L_K + hi * 1024 + r32 * 16;
    lds_u8* vp0 = lds + L_V + ((lane >> 4) & 1) * 32 + (lane & 3) * 8 + (4 * hi + ((lane & 15) >> 2)) * 64;
    LAS float* wsf = (LAS float*)(lds + L_WSF) + wid * 64;
    const int qrel = 32 * wid + r32;
    f32x16 o[3], negm, P0, P1;
#pragma unroll
    for (int r = 0; r < 16; ++r) { o[0][r] = 0.f; o[1][r] = 0.f; o[2][r] = 0.f; }
    const bf16x8 ones = {0x3F80, 0x3F80, 0x3F80, 0x3F80, 0x3F80, 0x3F80, 0x3F80, 0x3F80};
    float m_ref;
    DMA_K(2, 2); DMA_V(1, 1);
    {
        f32x16 S0, S1;
#pragma unroll
        for (int r = 0; r < 16; ++r) { S0[r] = 0.f; S1[r] = 0.f; }
        qk_tile<6>(S0, S1, kp0, qr);
        if (NT == 4) { const int thr = qrel - 4 * hi;
#pragma unroll
            for (int r = 0; r < 16; ++r) { const int kc = (r & 3) + 8 * (r >> 2); if (kc > thr) S0[r] = -INFINITY; if (kc + 32 > thr) S1[r] = -INFINITY; } }
        float rm = fmaxf(max16(S0), max16(S1)); rm = fmaxf(rm, __shfl_xor(rm, 32));
        m_ref = rm;
#pragma unroll
        for (int r = 0; r < 16; ++r) { P0[r] = ex2(S0[r] - rm); P1[r] = ex2(S1[r] - rm); negm[r] = -rm; }
    }
    WAIT_SYNC_AHEAD();
    for (int t = 1; t < NT; ++t) {
        const bool ahead = (t + 2 < NT);
        if (ahead) { DMA_K(t + 2, (t + 2) & 3); DMA_V(t + 1, (t + 1) & 3); } else if (t + 1 < NT) DMA_V(t + 1, (t + 1) & 3);
        if (t < Tw) {
            f32x16 S0, S1;
            qk_tile_c<6>(S0, S1, kp0 + (t & 3) * KBUF, qr, negm);
            __builtin_amdgcn_iglp_opt(0);
            const bf16x8 pa0 = pk8(P0, 0), pa1 = pk8(P0, 8), pa2 = pk8(P1, 0), pa3 = pk8(P1, 8);
            const int jb = t - (NT - 4);
            if (jb >= 0) { const int thr = qrel - 64 * jb - 4 * hi;
#pragma unroll
                for (int r = 0; r < 16; ++r) { const int kc = (r & 3) + 8 * (r >> 2); if (kc > thr) S0[r] = -INFINITY; if (kc + 32 > thr) S1[r] = -INFINITY; } }
            float rm = rowmax32(S0, S1); rm = fmaxf(rm, __shfl_xor(rm, 32));
            bool resc = false;
            if (__any(rm > 8.0f)) {
                const float dl = fmaxf(rm, 0.f); m_ref += dl;
#pragma unroll
                for (int r = 0; r < 16; ++r) { S0[r] -= dl; S1[r] -= dl; negm[r] = -m_ref; }
                const float f = ex2(-dl); if (hi == 0) wsf[r32] = f; resc = true;
            }
            __builtin_amdgcn_iglp_opt(0);
            pv_tile5(o, vp0 + ((t - 1) & 3) * VBUF, pa0, pa1, pa2, pa3, ones);
#pragma unroll
            for (int r = 0; r < 16; ++r) { P0[r] = ex2(S0[r]); P1[r] = ex2(S1[r]); }
            if (resc) {
#pragma unroll
                for (int r = 0; r < 16; ++r) { const float fr_ = wsf[(r & 3) + 8 * (r >> 2) + 4 * hi]; o[0][r] *= fr_; o[1][r] *= fr_; o[2][r] *= fr_; }
            }
        } else if (t == Tw) {
            pv_tile5(o, vp0 + ((t - 1) & 3) * VBUF, pk8(P0, 0), pk8(P0, 8), pk8(P1, 0), pk8(P1, 8), ones);
        }
        if (ahead) WAIT_SYNC_AHEAD(); else WAIT_SYNC();
    }
    if (Tw == NT) pv_tile5(o, vp0 + ((NT - 1) & 3) * VBUF, pk8(P0, 0), pk8(P0, 8), pk8(P1, 0), pk8(P1, 8), ones);
    float rli[16];
#pragma unroll
    for (int r = 0; r < 16; ++r) rli[r] = __builtin_amdgcn_rcpf(o[2][r]);
    store_o(lds, ws, o, rli, rowbase, q0, wid, lane, r32, hi, 0, h, OFF_SSQ_MLA);
    __syncthreads();
#undef DMA16
#undef DMA_K
#undef DMA_V
#undef WAIT_SYNC
#undef WAIT_SYNC_AHEAD
}

constexpr int SBW = 7, SB_K = 0, SB_V = SBW * 8192;
static_assert(SB_V + SBW * 8192 <= L_FLAG, "SB window");
__device__ __forceinline__ void sb_unit(lds_u8* lds, unsigned char* ws, int b, int h, int qb) {
    const int tid = threadIdx.x, lane = tid & 63, r32 = lane & 31, hi = lane >> 5; const int wid = __builtin_amdgcn_readfirstlane(tid >> 6);
    const size_t rowbase = (size_t)b * SEQ; const int q0 = qb * 256;
    const bf16_t* Qb = WSP(const bf16_t, WS_QSB) + (rowbase + q0) * 512 + h * 64;
    const char* Kb = (const char*)(WSP(const bf16_t, WS_KSB) + rowbase * 512 + h * 64);
    const char* Vb = (const char*)(WSP(const bf16_t, WS_VSB) + rowbase * 512 + h * 64);
    const unsigned koff = (unsigned)(lane * 512 + wid * 8) * 2u, voff = (unsigned)((16 * (wid & 3) + (lane >> 2)) * 512 + (wid >> 2) * 32 + (lane & 3) * 8) * 2u;
#define SB_DMA(t, slot) do { glds16(Kb + (koff + (unsigned)(t) * (64u * 1024u)), (unsigned)__builtin_amdgcn_readfirstlane((int)(unsigned)(uintptr_t)(lds + SB_K + (slot) * 8192 + wid * 1024))); \
        glds16(Vb + (voff + (unsigned)(t) * (64u * 1024u)), (unsigned)__builtin_amdgcn_readfirstlane((int)(unsigned)(uintptr_t)(lds + SB_V + (slot) * 8192 + wid * 1024))); } while (0)
    const int NT = 4 * (qb + 1);
    const int W = (NT < SBW) ? NT : SBW;
    for (int i = 0; i < W; ++i) SB_DMA(NT - 1 - i, i);
    bf16x8 qr[4];
#pragma unroll
    for (int d0 = 0; d0 < 4; ++d0) qr[d0] = *(const bf16x8*)(Qb + (unsigned)((wid * 32 + r32) * 512 + d0 * 16 + hi * 8));
    asm volatile("s_waitcnt vmcnt(0)" ::: "memory"); __syncthreads();
    lds_u8* kp0 = lds + SB_K + hi * 1024 + r32 * 16;
    lds_u8* vp0 = lds + SB_V + ((lane >> 4) & 1) * 32 + (lane & 3) * 8 + (4 * hi + ((lane & 15) >> 2)) * 64;
    f32x16 o[2];
#pragma unroll
    for (int r = 0; r < 16; ++r) { o[0][r] = 0.f; o[1][r] = 0.f; }
    const int qrel = 32 * wid + r32;
    float c = 1.f; bool wdone = false;
    for (int i = 3 - (wid >> 1); i < W && !wdone; ++i) {
        const int jb = 3 - i;
        f32x16 p0, p1;
#pragma unroll
        for (int r = 0; r < 16; ++r) { p0[r] = 0.f; p1[r] = 0.f; }
        qk_tile<4>(p0, p1, kp0 + i * 8192, qr);
        sb_transform(p0, p1, c, hi, jb >= 0, 64 * jb + 4 * hi, qrel);
        pv_tile(o, vp0 + i * 8192, p0, p1);
        wdone = __all(c == 0.f);
    }
    LAS int* flags = (LAS int*)(lds + L_FLAG);
    if (lane == 0) flags[wid] = wdone ? 1 : 0;
    __syncthreads();
    int alld = 1;
#pragma unroll
    for (int w = 0; w < 8; ++w) alld &= flags[w];
    for (int t = NT - 1 - W; t >= 0 && !alld; --t) {
        SB_DMA(t, 0);
        asm volatile("s_waitcnt vmcnt(0)" ::: "memory"); __syncthreads();
        if (!wdone) {
            f32x16 p0, p1;
#pragma unroll
            for (int r = 0; r < 16; ++r) { p0[r] = 0.f; p1[r] = 0.f; }
            qk_tile<4>(p0, p1, kp0, qr);
            sb_transform(p0, p1, c, hi, false, 0, qrel);
            pv_tile(o, vp0, p0, p1);
            wdone = __all(c == 0.f);
        }
        if (lane == 0) flags[8 + wid] = wdone ? 1 : 0;
        __syncthreads();
        alld = 1;
#pragma unroll
        for (int w = 0; w < 8; ++w) alld &= flags[8 + w];
    }
    float rli[16];
#pragma unroll
    for (int r = 0; r < 16; ++r) rli[r] = 1.f;
    store_o(lds, ws, o, rli, rowbase, q0, wid, lane, r32, hi, 512, h, OFF_SSQ_SB);
    __syncthreads();
#undef SB_DMA
}

__device__ __forceinline__ int attn_phase(lds_u8* lds, unsigned char* ws) {
    for (;;) {
        if (threadIdx.x == 0) *(LAS unsigned*)(lds + L_UNIT) = atomicAdd(WSP(unsigned, OFF_CTR), 1u);
        __syncthreads();
        const int idx = __builtin_amdgcn_readfirstlane((int)*(LAS unsigned*)(lds + L_UNIT));
        __syncthreads();
        if (idx >= 1024) return idx;
        const int i2 = idx & 511, qb = 31 - (i2 >> 4), bh = i2 & 15;
#if !defined(ATT_ONLY) || ATT_ONLY == 0
        if (idx < 512) mla_unit(lds, ws, bh >> 3, bh & 7, qb);
#endif
#if !defined(ATT_ONLY) || ATT_ONLY == 1
        if (idx >= 512) sb_unit(lds, ws, bh >> 3, bh & 7, qb);
#endif
    }
}
}


constexpr int LDSCTL_OFF = 131072;
constexpr int LDS_BYTES = 147456;
constexpr int NWAVES = 8;

__device__ __forceinline__ float wave_sum(float v) {
#pragma unroll
    for (int o = 1; o < 64; o <<= 1) v += __shfl_xor(v, o);
    return v;
}
#define LDS_WAIT() asm volatile("s_waitcnt lgkmcnt(0)" ::: "memory")
__device__ __forceinline__ void tr_item(const float* W, int ldw, int k0, int n0, const float* gk, bf16_t* WT, int ldt, int drow0, int dcol0, bool il, LAS float* scr, int lane) {
    const int ks = lane >> 3, n4 = lane & 7;
    f32x4 w[8];
#pragma unroll
    for (int i = 0; i < 8; ++i) w[i] = __builtin_nontemporal_load((const f32x4*)(W + (size_t)(k0 + 8 * i + ks) * ldw + n0 + 4 * n4));
#pragma unroll
    for (int i = 0; i < 8; ++i) { const int kk = 8 * i + ks; const float g = gk ? gk[kk] : 1.f; LAS float* s = scr + kk * 33 + 4 * n4;
        s[0] = w[i][0] * g; s[1] = w[i][1] * g; s[2] = w[i][2] * g; s[3] = w[i][3] * g; }
    LDS_WAIT();
    const int c = lane & 7;
#pragma unroll
    for (int j = 0; j < 4; ++j) { const int n = (lane >> 3) + 8 * j; const LAS float* s = scr + (8 * c) * 33 + n;
        u32x4 o; o.x = cvtpk(s[0 * 33], s[1 * 33]); o.y = cvtpk(s[2 * 33], s[3 * 33]); o.z = cvtpk(s[4 * 33], s[5 * 33]); o.w = cvtpk(s[6 * 33], s[7 * 33]);
        const int drow = drow0 + (il ? (8 * (n >> 2) + (n & 3)) : n);
        *(u32x4*)(WT + (size_t)drow * ldt + dcol0 + 8 * c) = o; }
    LDS_WAIT();
}

#define XB_TMO      128
#define XB_XCNT(j)  (256  + 64 * (j))
#define XB_XSUB(j)  (1280 + 64 * (j))
#define XB_XGEN(j)  (2304 + 64 * (j))
#define XB_TOP      3328
#define XB_TOPGEN   3392
#define XCD_BAR_WORDS 3456
#define XB_SPIN_CAP (1u << 18)

__device__ __forceinline__ unsigned xb_ld(unsigned* p)              { return __hip_atomic_load(p, __ATOMIC_RELAXED, __HIP_MEMORY_SCOPE_AGENT); }
__device__ __forceinline__ unsigned xb_add(unsigned* p, unsigned v) { return __hip_atomic_fetch_add(p, v, __ATOMIC_RELAXED, __HIP_MEMORY_SCOPE_AGENT); }
__device__ __forceinline__ unsigned xb_xcc_id() { return (unsigned)__builtin_amdgcn_s_getreg((3 << 11) | 20) & 0xFu; }
#define XB_SPIN(cond, bar) do { unsigned _sp = 0; while (cond) { __builtin_amdgcn_s_sleep(1); \
    if ((++_sp & 255u) == 0u) { if (xb_ld(&(bar)[XB_TMO])) break; if (_sp > XB_SPIN_CAP) { atomicAdd(&(bar)[XB_TMO], 1u); break; } } } } while (0)

struct XcdBarrier {
    unsigned* bar; unsigned x;
    volatile LAS unsigned* st;
};

__device__ __forceinline__ XcdBarrier xcd_barrier_post(unsigned* bar, volatile LAS unsigned* st) {
    XcdBarrier b; b.bar = bar; b.x = xb_xcc_id(); b.st = st;
    if (threadIdx.x == 0) (void)xb_add(&bar[XB_XCNT(b.x)], 1u);
    return b;
}
__device__ __forceinline__ void xcd_barrier_complete(unsigned* bar, unsigned x, unsigned& nloc, unsigned& nx) {
    const unsigned G = gridDim.x * gridDim.y * gridDim.z;
    unsigned sum, cnt, mine, sp = 0u;
    for (;;) {
        sum = 0u; cnt = 0u; mine = 0u;
#pragma unroll
        for (unsigned j = 0; j < 16; ++j) { const unsigned c = xb_ld(&bar[XB_XCNT(j)]); sum += c; cnt += (c > 0u) ? 1u : 0u; mine = (j == x) ? c : mine; }
        if (sum == G) break;
        __builtin_amdgcn_s_sleep(1);
        if ((++sp & 255u) == 0u) { if (xb_ld(&bar[XB_TMO])) break; if (sp > XB_SPIN_CAP) { atomicAdd(&bar[XB_TMO], 1u); break; } }
    }
    nloc = mine > 0u ? mine : 1u; nx = cnt > 0u ? cnt : 1u;
}

__device__ __forceinline__ void xcd_barrier(const XcdBarrier& b) {
    asm volatile("s_waitcnt vmcnt(0)" ::: "memory");
    __syncthreads();
    if (threadIdx.x == 0) {
        unsigned* bar = b.bar;
        __builtin_amdgcn_s_waitcnt(0);
        unsigned nloc = b.st[0], nx = b.st[1];
        if (nloc == 0u) { xcd_barrier_complete(bar, b.x, nloc, nx); b.st[0] = nloc; b.st[1] = nx; }
        const unsigned old = xb_add(&bar[XB_XSUB(b.x)], 1u);
        const unsigned gen = old / nloc;
        if (old + 1u == (gen + 1u) * nloc) {
            __builtin_amdgcn_fence(__ATOMIC_RELEASE, "agent");
            asm volatile("s_waitcnt vmcnt(0)" ::: "memory");
            const unsigned og = xb_add(&bar[XB_TOP], 1u);
            const unsigned tg = og / nx;
            if (og + 1u == (tg + 1u) * nx) xb_add(&bar[XB_TOPGEN], 1u);
            else XB_SPIN(xb_ld(&bar[XB_TOPGEN]) == tg, bar);
            __builtin_amdgcn_fence(__ATOMIC_ACQUIRE, "agent");
            xb_add(&bar[XB_XGEN(b.x)], 1u);
            asm volatile("s_waitcnt vmcnt(0)" ::: "memory");
        } else {
            XB_SPIN(xb_ld(&bar[XB_XGEN(b.x)]) == gen, bar);
            __builtin_amdgcn_fence(__ATOMIC_ACQUIRE, "agent");
            asm volatile("s_waitcnt vmcnt(0)" ::: "memory");
        }
    }
    __syncthreads();
}

#define CONV_ITEMS(lo, hi, first, stride) do { \
    LAS float* scr_ = (LAS float*)(lds + wave * 16384); \
    constexpr int J1 = 16 * 61, J2 = 4 * 24, J3 = 2 * 32, J4 = 16 * 32, J5 = 16 * 88, J6 = 16 * 88; \
    for (int it_ = (lo) + (first); it_ < (hi); it_ += (stride)) { int r = it_; \
        if (r < J1) { const int kb = r / 61, nb = r % 61, n0 = 32 * nb; tr_item(w_in, 1952, 64 * kb, n0, norm_mix + 64 * kb, WIN, 1024, n0 + (n0 >= 416 ? 96 : 0), 64 * kb, false, scr_, lane); continue; } r -= J1; \
        if (r < J2) { const int kb = r / 24, nb = r % 24; tr_item(w_uq, 768, 64 * kb, 32 * nb, qln + 64 * kb, WUP, 256, 32 * nb, 64 * kb, false, scr_, lane); continue; } r -= J2; \
        if (r < J3) { const int kb = r / 32, nb = r % 32; tr_item(w_ukv, 1024, 64 * kb, 32 * nb, kvln + 64 * kb, WUP + 768 * 256, 128, 32 * nb, 64 * kb, false, scr_, lane); continue; } r -= J3; \
        if (r < J4) { const int kb = r / 32, nb = r % 32; tr_item(w_o, 1024, 64 * kb, 32 * nb, (kb < 8 ? on_mla + 64 * kb : on_sb + 64 * (kb - 8)), WO, 1024, 32 * nb, 64 * kb, false, scr_, lane); continue; } r -= J4; \
        if (r < J5) { const int kb = r / 88, nb = r % 88; tr_item(w_gate, DFF, 64 * kb, 32 * nb, norm_ffn + 64 * kb, WGU, 1024, 64 * nb, 64 * kb, true, scr_, lane); continue; } r -= J5; \
        if (r < J6) { const int kb = r / 88, nb = r % 88; tr_item(w_up, DFF, 64 * kb, 32 * nb, norm_ffn + 64 * kb, WGU, 1024, 64 * nb + 4, 64 * kb, true, scr_, lane); continue; } r -= J6; \
        { const int kb = r / 32, nb = r % 32; tr_item(w_down, 1024, 64 * kb, 32 * nb, nullptr, WD, DFF, 32 * nb, 64 * kb, false, scr_, lane); } } } while (0)
#define CONV_BY_IDLE(nwg, lo, hi) do { const int rem_ = (nwg) % G, fi_ = rem_ ? rem_ : 0, ni_ = rem_ ? G - rem_ : G; \
    if ((int)blockIdx.x >= fi_) CONV_ITEMS(lo, hi, ((int)blockIdx.x - fi_) * NWAVES + wave, ni_ * NWAVES); } while (0)

struct Args { const float* in[16]; float* out; unsigned char* ws; };

__global__ void __launch_bounds__(NWAVES * 64, 2) mk_fwd(Args a) {
    extern __shared__ __attribute__((aligned(16))) unsigned char lds_raw[];
    LAS unsigned char* lds = (LAS unsigned char*)lds_raw;
    cg::grid_group grid = cg::this_grid();
    const int tid = threadIdx.x, lane = tid & 63; const int wave = __builtin_amdgcn_readfirstlane(tid >> 6);
    const int G = gridDim.x;
    unsigned char* ws = a.ws;
    for (int u = tid; u < (LDS_BYTES - LDSCTL_OFF) / 4; u += NWAVES * 64) ((LAS unsigned*)(lds + LDSCTL_OFF))[u] = 0u;
    __syncthreads();
    const XcdBarrier bar = xcd_barrier_post((unsigned*)(ws + OFF_BAR), (volatile LAS unsigned*)(lds + LDSCTL_OFF + 352));
    const float* x = a.in[0]; const int* positions = (const int*)a.in[1];
    const float *norm_mix = a.in[2], *w_in = a.in[3], *qln = a.in[4], *w_uq = a.in[5], *kvln = a.in[6], *w_ukv = a.in[7], *on_mla = a.in[8], *on_sb = a.in[9],
                *w_o = a.in[10], *norm_ffn = a.in[11], *w_gate = a.in[12], *w_up = a.in[13], *w_down = a.in[14], *norm_final = a.in[15];
    float* out = a.out;
    bf16_t *WIN = (bf16_t*)(ws + WS_WIN), *WUP = (bf16_t*)(ws + WS_WUP), *WO = (bf16_t*)(ws + WS_WO), *WGU = (bf16_t*)(ws + WS_WGU), *WD = (bf16_t*)(ws + WS_WD);
    float2* CS = (float2*)(ws + WS_CS);
    bf16_t *XN = (bf16_t*)(ws + WS_XN), *H1B = (bf16_t*)(ws + WS_H1B), *CQKV = (bf16_t*)(ws + WS_CQKV), *OMIX = (bf16_t*)(ws + WS_OMIX), *ACT = (bf16_t*)(ws + WS_ACT);

    {
        const int gw = blockIdx.x * NWAVES + wave, NGW = G * NWAVES;
        constexpr int I1 = 16 * 61, I2 = 4 * 24, I3 = 2 * 32, I4 = 16 * 32, I5 = 16 * 88, I6 = 16 * 88, I7 = 44 * 32;
        CONV_ITEMS(0, I1 + I2 + I3, gw, NGW);
        const int gt = blockIdx.x * (NWAVES * 64) + tid, NGT = G * NWAVES * 64; const u32x4 z4 = {0u, 0u, 0u, 0u};
        for (int i = gt; i < 96 * 128; i += NGT) *(u32x4*)(WIN + (size_t)416 * 1024 + (size_t)i * 8) = z4;
        for (int i = gt; i < M * 16; i += NGT) { const int row = i >> 4, k = i & 15; const float inv = __builtin_amdgcn_exp2f(-(float)k * 0.8304820237218405f); const float ang = (float)positions[row] * inv;
            double tr = (double)ang * 0.15915494309189535; tr -= __builtin_floor(tr); const float fr_ = (float)tr;
            CS[i] = make_float2(__builtin_amdgcn_cosf(fr_), __builtin_amdgcn_sinf(fr_)); }
        for (int m = 4 * gw; m < M; m += 4 * NGW) {
            const f32x4* xr = (const f32x4*)(x + (size_t)m * DM) + lane;
            f32x4 v[4][4];
#pragma unroll
            for (int r = 0; r < 4; ++r)
#pragma unroll
                for (int j = 0; j < 4; ++j) v[r][j] = __builtin_nontemporal_load(xr + 256 * r + 64 * j);
            u32x2* o8 = (u32x2*)(XN + (size_t)m * DM) + lane;
#pragma unroll
            for (int r = 0; r < 4; ++r) { float sr = 0.f;
#pragma unroll
                for (int j = 0; j < 4; ++j) { const f32x4 y = v[r][j]; sr += sq4(y); u32x2 w; w.x = cvtpk(y[0], y[1]); w.y = cvtpk(y[2], y[3]); o8[256 * r + 64 * j] = w; }
                const float t = wave_sum(sr);
                if (lane == 0) ((float*)(ws + OFF_SSQ_X))[m + r] = t; }
        }
    }
    if (ws == nullptr) grid.sync();
    xcd_barrier(bar);
    { pg8::Gemm g{XN, WIN, M, N_IN, DM}; pg8::StaticOrder S; S.init(M, N_IN, G, (int)blockIdx.x);
      EpiProj E{ws};
      pg8::gemm_phase<EpiProj, pg8::StaticOrder, true, true>(lds, g, S, E); }
    xcd_barrier(bar);
    { int kq_ = 256; asm volatile("" : "+s"(kq_));
      pg8::Gemm g{CQKV, WUP, M, 768, kq_}; pg8::StaticOrder S; S.init(M, 768, G, (int)blockIdx.x);
      EpiUp E{ws, 0};
      pg8::gemm_phase<EpiUp, pg8::StaticOrder, true, true>(lds, g, S, E); }
    CONV_BY_IDLE((M / 256) * (768 / 256), 976 + 96 + 64, 976 + 96 + 64 + 512);
    __syncthreads();
    { int kk_ = 128; asm volatile("" : "+s"(kk_));
      pg8::Gemm g{CQKV + (size_t)M * 256, WUP + 768 * 256, M, 1024, kk_}; pg8::StaticOrder S; S.init(M, 1024, G, (int)blockIdx.x);
      EpiUp E{ws, 3};
      pg8::gemm_phase<EpiUp, pg8::StaticOrder, true, true>(lds, g, S, E); }
    xcd_barrier(bar);
    {
        int idx = att::attn_phase(lds, ws);
        constexpr int CB0 = 976 + 96 + 64 + 512, NCB = 2816 / NWAVES;
        LAS unsigned* qw = (LAS unsigned*)(lds + LDSCTL_OFF + 2048);
        while (idx < 1024 + NCB) {
            { const int one_ = CB0 + (idx - 1024) * NWAVES + wave; CONV_ITEMS(one_, one_ + 1, 0, 1); }
            if (tid == 0) *qw = atomicAdd((unsigned*)(ws + OFF_CTR), 1u);
            __syncthreads();
            idx = __builtin_amdgcn_readfirstlane((int)*qw);
            __syncthreads();
        }
    }
    xcd_barrier(bar);
    { pg8::Gemm g{OMIX, WO, M, DM, DM}; pg8::StaticOrder S; S.init(M, DM, G, (int)blockIdx.x);
      EpiWo E{x, out, ws};
      pg8::gemm_phase<EpiWo, pg8::StaticOrder, true, true>(lds, g, S, E); }
    xcd_barrier(bar);
    { pg8::Gemm g{H1B, WGU, M, N_GU, DM}; pg8::StaticOrder S; S.init(M, N_GU, G, (int)blockIdx.x);
      EpiGU E{ws};
      pg8::gemm_phase<EpiGU, pg8::StaticOrder, true, true>(lds, g, S, E); }
    CONV_BY_IDLE((M / 256) * (N_GU / 256), 976 + 96 + 64 + 512 + 2816, 976 + 96 + 64 + 512 + 2816 + 1408);
    xcd_barrier(bar);
    if (G == 256) {
        pg8::Gemm g{ACT, WD, M, DM, DFF}; pg8::StaticOrder S; S.init(M, DM, G, (int)blockIdx.x);
        EpiDownNorm E{out, norm_final, ws};
        pg8::gemm_phase<EpiDownNorm, pg8::StaticOrder, false, true>(lds, g, S, E);
    } else {
        { pg8::Gemm g{ACT, WD, M, DM, DFF}; pg8::StaticOrder S; S.init(M, DM, G, (int)blockIdx.x);
          EpiDown E{out, ws};
          pg8::gemm_phase<EpiDown, pg8::StaticOrder, true, true>(lds, g, S, E); }
        xcd_barrier(bar);
        const int gw = blockIdx.x * NWAVES + wave, NGW = G * NWAVES;
        for (int m = 2 * gw; m < M; m += 2 * NGW) {
            f32x4* xr = (f32x4*)(out + (size_t)m * DM) + lane; const f32x4* gr = (const f32x4*)norm_final + lane;
            f32x4 v[2][4]; float s0 = 0.f, s1 = 0.f;
#pragma unroll
            for (int j = 0; j < 4; ++j) { v[0][j] = xr[64 * j]; v[1][j] = xr[256 + 64 * j]; }
#pragma unroll
            for (int j = 0; j < 4; ++j) { s0 += sq4(v[0][j]); s1 += sq4(v[1][j]); }
            const float rs0 = 1.0f / __builtin_sqrtf(wave_sum(s0) * (1.f / DM) + EPS), rs1 = 1.0f / __builtin_sqrtf(wave_sum(s1) * (1.f / DM) + EPS);
#pragma unroll
            for (int j = 0; j < 4; ++j) { const f32x4 g = gr[64 * j]; xr[64 * j] = (v[0][j] * rs0) * g; xr[256 + 64 * j] = (v[1][j] * rs1) * g; }
        }
    }
}

extern "C" void kernel_launch(void* const* d_in, const int* in_sizes, int n_in, void* d_out, int out_size, void* d_ws, size_t ws_size, hipStream_t stream) {
    static int grid = 0;
    if (grid == 0) {
        if (n_in != 16 || out_size != M * DM || ws_size < WS_END) { fprintf(stderr, "kernel_launch: unexpected shapes (n_in %d out %d ws %zu)\n", n_in, out_size, ws_size); grid = -1; return; }
        int dev = 0, cus = 0, per_cu = 0;
        if (hipGetDevice(&dev) != hipSuccess || hipDeviceGetAttribute(&cus, hipDeviceAttributeMultiprocessorCount, dev) != hipSuccess) { grid = -1; return; }
        if (hipFuncSetAttribute((const void*)mk_fwd, hipFuncAttributeMaxDynamicSharedMemorySize, LDS_BYTES) != hipSuccess) { fprintf(stderr, "kernel_launch: hipFuncSetAttribute failed\n"); grid = -1; return; }
        if (hipOccupancyMaxActiveBlocksPerMultiprocessor(&per_cu, (const void*)mk_fwd, NWAVES * 64, LDS_BYTES) != hipSuccess || per_cu < 1) { fprintf(stderr, "kernel_launch: occupancy query gave %d\n", per_cu); per_cu = 1; }
        (void)hipGetLastError();
        grid = cus * per_cu;
    }
    if (grid < 0) return;
    (void)hipMemsetAsync((char*)d_ws + WS_CTL, 0, CTL_ZERO_BYTES, stream);
    Args a{};
    for (int i = 0; i < 16; ++i) a.in[i] = (const float*)d_in[i];
    a.out = (float*)d_out; a.ws = (unsigned char*)d_ws;
    void* args[] = {&a};
    hipError_t e = hipLaunchCooperativeKernel((const void*)mk_fwd, dim3(grid), dim3(NWAVES * 64), args, LDS_BYTES, stream);
    if (e != hipSuccess) fprintf(stderr, "cooperative launch failed: %s (grid %d)\n", hipGetErrorString(e), grid);
}
```
